# Optimizing an MI355X kernel written in HIP

```python
import math
import jax, jax.numpy as jnp
from jax import lax
import numpy as np

D_MODEL = 1024
BATCH = 8
SEQ = 4096
DEPTH = 1

N_ATT_HEADS = 4
ATT_DK = 64
ATT_DV = 2 * ATT_DK
ATT_QK_W = N_ATT_HEADS * 2 * ATT_DK
ATT_V_W = N_ATT_HEADS * ATT_DV
Q_BLOCK = 128
CHUNK = 128
SGU_GROUPS = 4
SGU_GROUP_DIM = 128
SGU_W = SGU_GROUPS * SGU_GROUP_DIM
IN_W = 2 * ATT_QK_W + ATT_V_W + 2 * SGU_W
BRANCH_W = ATT_V_W + SGU_W
N_EXPERTS = 16
CAP_FACTOR = 2
D_FF_EXPERT = 2048
EPS = 1e-6

kernel_name = "hybrid_diffattn_sgu_ec_moe_encoder"


def rms_norm(x, g):
    xf = x.astype(jnp.float32)
    y = xf * lax.rsqrt(jnp.mean(xf * xf, axis=-1, keepdims=True) + EPS)
    return (y * g.astype(jnp.float32)).astype(x.dtype)


def layer_norm(x, g, b):
    xf = x.astype(jnp.float32)
    mu = jnp.mean(xf, axis=-1, keepdims=True)
    xc = xf - mu
    y = xc * lax.rsqrt(jnp.mean(xc * xc, axis=-1, keepdims=True) + EPS)
    return (y * g.astype(jnp.float32) + b.astype(jnp.float32)).astype(x.dtype)


def alibi_slopes(n_heads):
    return jnp.array([2.0 ** (-8.0 * (i + 1) / n_heads) for i in range(n_heads)], dtype=jnp.float32)


def diff_attention(q, k, v, lam, slopes):
    B, S = q.shape[0], q.shape[1]
    nb = S // Q_BLOCK
    q = q * (ATT_DK ** -0.5)
    qb = q.reshape(B, nb, Q_BLOCK, N_ATT_HEADS, 2, ATT_DK).transpose(1, 0, 3, 4, 2, 5)
    kt = k.transpose(0, 2, 3, 1, 4)
    vt = v.transpose(0, 2, 1, 3)
    kpos = jnp.arange(S, dtype=jnp.float32)

    def block(args):
        qblk, start = args
        qpos = start + jnp.arange(Q_BLOCK, dtype=jnp.float32)
        bias = -slopes[:, None, None, None] * jnp.abs(qpos[:, None] - kpos[None, :])
        s = jnp.einsum('bhcqd,bhckd->bhcqk', qblk, kt).astype(jnp.float32) + bias
        p = jax.nn.softmax(s, axis=-1)
        a = p[:, :, 0] - lam * p[:, :, 1]
        return jnp.einsum('bhqk,bhkd->bhqd', a.astype(vt.dtype), vt)

    starts = jnp.arange(nb, dtype=jnp.float32) * Q_BLOCK
    o = lax.map(block, (qb, starts))
    return o.transpose(1, 0, 3, 2, 4).reshape(B, S, N_ATT_HEADS, ATT_DV)


def spatial_gating(u, s, ln_g, ln_b, w_s, b_s):
    B, S, _ = s.shape
    s = layer_norm(s, ln_g, ln_b)
    sc = s.reshape(B, S // CHUNK, CHUNK, SGU_GROUPS, SGU_GROUP_DIM)
    z = jnp.einsum('gts,bcsgd->bctgd', w_s, sc) + b_s.T[None, None, :, :, None]
    return u * z.reshape(B, S, SGU_W)


def expert_choice_ffn(h, w_router, w_gate, w_up, w_down):
    B, S, D = h.shape
    cap = CAP_FACTOR * S // N_EXPERTS
    logits = jnp.einsum('bsd,de->bse', h, w_router).astype(jnp.float32)
    aff = jax.nn.softmax(logits, axis=-1)
    g, idx = lax.top_k(aff.transpose(0, 2, 1), cap)
    xs = jax.vmap(lambda hb, ib: hb[ib])(h, idx)
    a = jnp.einsum('becd,edf->becf', xs, w_gate)
    u = jnp.einsum('becd,edf->becf', xs, w_up)
    y = jnp.einsum('becf,efd->becd', jax.nn.silu(a) * u, w_down)
    y = y * g[..., None].astype(y.dtype)
    return jax.vmap(lambda yb, ib: jnp.zeros((S, D), yb.dtype).at[ib.reshape(-1)].add(yb.reshape(-1, D)))(y, idx)


def setup_inputs(seed: int = 0) -> dict:
    key = jax.random.key(seed)
    ks = jax.random.split(key, 24)
    f32 = jnp.float32
    L, D = DEPTH, D_MODEL
    nrm = lambda k, shape, scale: jax.random.normal(k, shape, f32) * scale
    return {
        "x": jax.random.normal(ks[0], (BATCH, SEQ, D), f32),
        "norm_mix_g": 1.0 + nrm(ks[1], (L, D), 0.02),
        "w_in": nrm(ks[2], (L, D, IN_W), D ** -0.5),
        "w_gate": nrm(ks[3], (L, D, 2 * D), D ** -0.5),
        "b_gate": nrm(ks[4], (L, 2 * D), 0.02),
        "lam_q1": nrm(ks[5], (L, ATT_DK), 0.1),
        "lam_k1": nrm(ks[6], (L, ATT_DK), 0.1),
        "lam_q2": nrm(ks[7], (L, ATT_DK), 0.1),
        "lam_k2": nrm(ks[8], (L, ATT_DK), 0.1),
        "subln_g": 1.0 + nrm(ks[9], (L, ATT_DV), 0.02),
        "sgu_ln_g": 1.0 + nrm(ks[10], (L, SGU_W), 0.02),
        "sgu_ln_b": nrm(ks[11], (L, SGU_W), 0.02),
        "sgu_w": nrm(ks[12], (L, SGU_GROUPS, CHUNK, CHUNK), CHUNK ** -0.5),
        "sgu_b": 1.0 + nrm(ks[13], (L, SGU_GROUPS, CHUNK), 0.02),
        "w_branch": nrm(ks[14], (L, BRANCH_W, D), (BRANCH_W // 2) ** -0.5),
        "w_out": nrm(ks[15], (L, D, D), D ** -0.5),
        "norm_ffn_g": 1.0 + nrm(ks[16], (L, D), 0.02),
        "w_router": nrm(ks[17], (L, D, N_EXPERTS), D ** -0.5),
        "w_e_gate": nrm(ks[18], (L, N_EXPERTS, D, D_FF_EXPERT), D ** -0.5),
        "w_e_up": nrm(ks[19], (L, N_EXPERTS, D, D_FF_EXPERT), D ** -0.5),
        "w_e_down": nrm(ks[20], (L, N_EXPERTS, D_FF_EXPERT, D), D_FF_EXPERT ** -0.5),
        "final_norm_g": 1.0 + nrm(ks[21], (D,), 0.02),
    }


def reference(x, norm_mix_g, w_in, w_gate, b_gate, lam_q1, lam_k1, lam_q2, lam_k2, subln_g,
              sgu_ln_g, sgu_ln_b, sgu_w, sgu_b, w_branch, w_out, norm_ffn_g, w_router,
              w_e_gate, w_e_up, w_e_down, final_norm_g):
    B, S, D = x.shape
    slopes = alibi_slopes(N_ATT_HEADS)
    for l in range(DEPTH):
        h = rms_norm(x, norm_mix_g[l])
        proj = jnp.einsum('bsd,dn->bsn', h, w_in[l])
        o1 = ATT_QK_W
        o2 = o1 + ATT_QK_W
        o3 = o2 + ATT_V_W
        o4 = o3 + SGU_W
        q = proj[..., :o1].reshape(B, S, N_ATT_HEADS, 2, ATT_DK)
        k = proj[..., o1:o2].reshape(B, S, N_ATT_HEADS, 2, ATT_DK)
        v = proj[..., o2:o3].reshape(B, S, N_ATT_HEADS, ATT_DV)
        g_sgu = jax.nn.gelu(proj[..., o3:], approximate=False)
        u, s = g_sgu[..., :SGU_W], g_sgu[..., SGU_W:]

        lambda_init = 0.8 - 0.6 * math.exp(-0.3 * l)
        lam = (jnp.exp(jnp.sum(lam_q1[l].astype(jnp.float32) * lam_k1[l].astype(jnp.float32)))
               - jnp.exp(jnp.sum(lam_q2[l].astype(jnp.float32) * lam_k2[l].astype(jnp.float32)))
               + lambda_init)
        att = diff_attention(q, k, v, lam, slopes)
        att = (rms_norm(att, subln_g[l]) * (1.0 - lambda_init)).reshape(B, S, ATT_V_W)

        sgu = spatial_gating(u, s, sgu_ln_g[l], sgu_ln_b[l], sgu_w[l], sgu_b[l])

        gates = jax.nn.sigmoid(jnp.einsum('bsd,dn->bsn', h, w_gate[l]) + b_gate[l])
        y_att = jnp.einsum('bsc,cd->bsd', att, w_branch[l, :ATT_V_W])
        y_sgu = jnp.einsum('bsc,cd->bsd', sgu, w_branch[l, ATT_V_W:])
        mixed = gates[..., :D] * y_att + gates[..., D:] * y_sgu
        x = x + jnp.einsum('bsd,de->bse', mixed, w_out[l])

        h2 = rms_norm(x, norm_ffn_g[l])
        x = x + expert_choice_ffn(h2, w_router[l], w_e_gate[l], w_e_up[l], w_e_down[l])
    return rms_norm(x, final_norm_g)
```

```cpp
#include <hip/hip_runtime.h>
#include <cstdint>
#include <cstdio>
#include <cmath>

#ifndef MK_N_LAUNCHES
#define MK_N_LAUNCHES 1
#endif
#ifndef PROBE_REPEAT
#define PROBE_REPEAT 0
#endif
#ifndef USE_NAIVE_GEMM
#define USE_NAIVE_GEMM 0
#endif
#ifndef USE_NAIVE_ATTN
#define USE_NAIVE_ATTN 0
#endif
#ifndef USE_NAIVE_SGU
#define USE_NAIVE_SGU 0
#endif

#define GAS __attribute__((address_space(1)))
#define LAS __attribute__((address_space(3)))
typedef unsigned short bf16_t;
typedef short bf16x8 __attribute__((ext_vector_type(8)));
typedef short s16x4 __attribute__((ext_vector_type(4)));
typedef float f32x2 __attribute__((ext_vector_type(2)));
typedef float f32x4 __attribute__((ext_vector_type(4)));
typedef float f32x16 __attribute__((ext_vector_type(16)));
typedef unsigned u32x2 __attribute__((ext_vector_type(2)));
typedef unsigned u32x4 __attribute__((ext_vector_type(4)));

constexpr int NB = 8, SEQ = 4096, DM = 1024, MTOK = NB * SEQ;
constexpr int NCAT = 4608;
constexpr int NE = 16, CAP = 512, FF = 2048, MROWS = NB * NE * CAP;
constexpr float EPS = 1e-6f;
constexpr float LOG2E = 1.4426950408889634f;
constexpr float MOE_WSCALE = 64.f, MOE_HSCALE = 4.f, MOE_ASCALE = 8.f, MOE_YSCALE = 32.f;
constexpr float C2 = 0.125f * LOG2E;
constexpr int NWAVES = 8, NTHREADS = 512;
constexpr int NPHASE = 10;

constexpr size_t MiB = 1u << 20, KiB = 1u << 10;
constexpr size_t WS_CTL = 0, CTL_ZERO_BYTES = 1 * MiB;
constexpr size_t WS_WCAT = 2 * MiB;
constexpr size_t WS_WG8 = 7 * MiB;
constexpr size_t WS_WBR = 11 * MiB;
constexpr size_t WS_WOUT = 13 * MiB;
constexpr size_t WS_WSGU = 15 * MiB;
constexpr size_t WS_AFF = 16 * MiB;
constexpr size_t WS_IDX = 18 * MiB;
constexpr size_t WS_GV = 18 * MiB + 256 * KiB;
constexpr size_t WS_INV = 19 * MiB;
constexpr size_t WS_KN2 = 21 * MiB;
constexpr size_t WS_WGU = 22 * MiB;
constexpr size_t WS_WD = 150 * MiB;
constexpr size_t WS_Q = 214 * MiB, WS_K = 246 * MiB, WS_V = 278 * MiB, WS_U = 310 * MiB, WS_S = 342 * MiB;
constexpr size_t WS_GATES = 374 * MiB;
constexpr size_t WS_MIXED = 86 * MiB;
constexpr size_t WS_ACT = 214 * MiB;
constexpr size_t WS_H2 = 470 * MiB;
constexpr size_t WS_X1B = 374 * MiB;
constexpr size_t WS_Y = 86 * MiB;
constexpr size_t WS_END = 534 * MiB;
constexpr size_t DO_XN = 0;
constexpr size_t DO_BR = 0;
constexpr size_t DO_XN8 = 96 * MiB;
constexpr size_t DO_PARK = 64 * MiB;
constexpr int CW_BAR = 4096;

constexpr int RING_BYTES = 131072, LDS_BYTES = 147456, LDSCTL_OFF = LDS_BYTES - 512, MISC_OFF = LDSCTL_OFF + 320;

#define LDS_WAIT() asm volatile("s_waitcnt lgkmcnt(0)" ::: "memory")
#define VM_WAIT() asm volatile("s_waitcnt vmcnt(0)" ::: "memory")
#define SBAR() __builtin_amdgcn_sched_barrier(0)
__device__ __forceinline__ int tid_l() { int t_ = threadIdx.x; asm volatile("" : "+v"(t_)); return t_; }
typedef float f32x2v_t __attribute__((ext_vector_type(2))); typedef __bf16 bf16x2v_t __attribute__((ext_vector_type(2)));
__device__ __forceinline__ unsigned cvt_pk_bf16(float lo, float hi) { const f32x2v_t v = {lo, hi}; const bf16x2v_t b = __builtin_convertvector(v, bf16x2v_t); return __builtin_bit_cast(unsigned, b); }
__device__ __forceinline__ float bf2f(unsigned short b) { return __uint_as_float(((unsigned)b) << 16); }
__device__ __forceinline__ float bflo(unsigned w) { return __uint_as_float(w << 16); }
__device__ __forceinline__ float bfhi(unsigned w) { return __uint_as_float(w & 0xffff0000u); }
template <int X> __device__ __forceinline__ float swz_xor(float v) { return __int_as_float(__builtin_amdgcn_ds_swizzle(__float_as_int(v), (X << 10) | 0x1f)); }
__device__ __forceinline__ float half_sum(float v) { v += swz_xor<1>(v); v += swz_xor<2>(v); v += swz_xor<4>(v); v += swz_xor<8>(v); v += swz_xor<16>(v); return v; }
__device__ __forceinline__ float half_max(float v) { v = fmaxf(v, swz_xor<1>(v)); v = fmaxf(v, swz_xor<2>(v)); v = fmaxf(v, swz_xor<4>(v)); v = fmaxf(v, swz_xor<8>(v)); v = fmaxf(v, swz_xor<16>(v)); return v; }
__device__ __forceinline__ float wave_sum(float v) { v = half_sum(v); return __int_as_float(__builtin_amdgcn_readlane(__float_as_int(v), 0)) + __int_as_float(__builtin_amdgcn_readlane(__float_as_int(v), 32)); }
__device__ __forceinline__ float wave_max(float v) { v = half_max(v); return fmaxf(__int_as_float(__builtin_amdgcn_readlane(__float_as_int(v), 0)), __int_as_float(__builtin_amdgcn_readlane(__float_as_int(v), 32))); }
__device__ __forceinline__ f32x2 gelu_pk(f32x2 v) {
    const f32x2 av = __builtin_elementwise_abs(v), d = av * 0.2316418882f + 1.0f;
    f32x2 t; t.x = __builtin_amdgcn_rcpf(d.x); t.y = __builtin_amdgcn_rcpf(d.y);
    f32x2 q = t * 0.5307027145f + (-0.7265760135f); q = q * t + 0.7107068705f; q = q * t + (-0.142248368f); q = q * t + 0.127414796f; q = q * t;
    const f32x2 s = (v * v) * (-0.72134752044f);
    f32x2 e; e.x = __builtin_amdgcn_exp2f(s.x); e.y = __builtin_amdgcn_exp2f(s.y);
    const f32x2 m = v * (q * e), r = v - m;
    f32x2 o; o.x = v.x < 0.f ? m.x : r.x; o.y = v.y < 0.f ? m.y : r.y; return o;
}
__device__ __forceinline__ void gelu8(f32x4& v0, f32x4& v1) {
    float v[8] = {v0[0], v0[1], v0[2], v0[3], v1[0], v1[1], v1[2], v1[3]}, t[8], q[8], e[8];
#pragma unroll
    for (int i = 0; i < 8; ++i) t[i] = __builtin_amdgcn_rcpf(fmaf(fabsf(v[i]), 0.2316418882f, 1.0f));
#pragma unroll
    for (int i = 0; i < 8; ++i) e[i] = __builtin_amdgcn_exp2f((v[i] * v[i]) * (-0.72134752044f));
#pragma unroll
    for (int i = 0; i < 8; ++i) q[i] = fmaf(t[i], 0.5307027145f, -0.7265760135f);
#pragma unroll
    for (int i = 0; i < 8; ++i) q[i] = fmaf(q[i], t[i], 0.7107068705f);
#pragma unroll
    for (int i = 0; i < 8; ++i) q[i] = fmaf(q[i], t[i], -0.142248368f);
#pragma unroll
    for (int i = 0; i < 8; ++i) q[i] = fmaf(q[i], t[i], 0.127414796f);
#pragma unroll
    for (int i = 0; i < 8; ++i) q[i] = (q[i] * t[i]) * e[i];
#pragma unroll
    for (int i = 0; i < 8; ++i) v[i] = fmaf(-fabsf(v[i]), q[i], fmaxf(v[i], 0.f));
    v0 = (f32x4){v[0], v[1], v[2], v[3]}; v1 = (f32x4){v[4], v[5], v[6], v[7]};
}
__device__ __forceinline__ float sigmoidf_(float x) { return __builtin_amdgcn_rcpf(1.f + __builtin_amdgcn_exp2f(-LOG2E * x)); }

#define XB_TMO      128
#define XB_XCNT(j)  (256  + 64 * (j))
#define XB_XSUB(j)  (1280 + 64 * (j))
#define XB_XGEN(j)  (2304 + 64 * (j))
#define XB_TOP      3328
#define XB_TOPGEN   3392
#define XCD_BAR_WORDS 3456
#define XB_SPIN_CAP (1u << 18)
__device__ __forceinline__ unsigned xb_ld(unsigned* p)              { return __hip_atomic_load(p, __ATOMIC_RELAXED, __HIP_MEMORY_SCOPE_AGENT); }
__device__ __forceinline__ unsigned xb_add(unsigned* p, unsigned v) { return __hip_atomic_fetch_add(p, v, __ATOMIC_RELAXED, __HIP_MEMORY_SCOPE_AGENT); }
__device__ __forceinline__ unsigned xb_xcc_id() { return (unsigned)__builtin_amdgcn_s_getreg((3 << 11) | 20) & 0xFu; }
#define XB_SPIN(cond, bar) do { unsigned _sp = 0; while (cond) { __builtin_amdgcn_s_sleep(1); \
    if ((++_sp & 255u) == 0u) { if (xb_ld(&(bar)[XB_TMO])) break; if (_sp > XB_SPIN_CAP) { atomicAdd(&(bar)[XB_TMO], 1u); break; } } } } while (0)
struct XcdBarrier { unsigned* bar; unsigned x; volatile LAS unsigned* st; };
__device__ __forceinline__ XcdBarrier xcd_barrier_post(unsigned* bar, volatile LAS unsigned* st) {
    XcdBarrier b; b.bar = bar; b.x = xb_xcc_id(); b.st = st;
    if (threadIdx.x == 0) (void)xb_add(&bar[XB_XCNT(b.x)], 1u);
    return b;
}
__device__ __forceinline__ void xcd_barrier_complete(unsigned* bar, unsigned x, unsigned& nloc, unsigned& nx, unsigned& mask) {
    const unsigned G = gridDim.x * gridDim.y * gridDim.z;
    unsigned sum, cnt, mine, sp = 0u;
    for (;;) {
        sum = 0u; cnt = 0u; mine = 0u; mask = 0u;
#pragma unroll
        for (unsigned j = 0; j < 16; ++j) { const unsigned c = xb_ld(&bar[XB_XCNT(j)]); sum += c; cnt += (c > 0u) ? 1u : 0u; mask |= (c > 0u) ? (1u << j) : 0u; mine = (j == x) ? c : mine; }
        if (sum == G) break;
        __builtin_amdgcn_s_sleep(1);
        if ((++sp & 255u) == 0u) { if (xb_ld(&bar[XB_TMO])) break; if (sp > XB_SPIN_CAP) { atomicAdd(&bar[XB_TMO], 1u); break; } }
    }
    nloc = mine > 0u ? mine : 1u; nx = cnt > 0u ? cnt : 1u;
}
__device__ __forceinline__ void xcd_barrier(const XcdBarrier& b) {
    asm volatile("s_waitcnt vmcnt(0)" ::: "memory");
    __syncthreads();
    if (threadIdx.x == 0) {
        unsigned* bar = b.bar;
        __builtin_amdgcn_s_waitcnt(0);
        unsigned nloc = b.st[0], nx = b.st[1], mask = b.st[2];
        if (nloc == 0u) { xcd_barrier_complete(bar, b.x, nloc, nx, mask); b.st[0] = nloc; b.st[1] = nx; b.st[2] = mask; }
        const unsigned old = xb_add(&bar[XB_XSUB(b.x)], 1u);
        const unsigned gen = old / nloc;
        if (old + 1u == (gen + 1u) * nloc) {
            __builtin_amdgcn_fence(__ATOMIC_RELEASE, "agent");
            asm volatile("s_waitcnt vmcnt(0)" ::: "memory");
            const unsigned og = xb_add(&bar[XB_TOP], 1u);
            const unsigned tg = og / nx;
            if (og + 1u == (tg + 1u) * nx) {
#pragma unroll
                for (unsigned j = 0; j < 16; ++j) if ((mask >> j) & 1u) (void)xb_add(&bar[XB_XGEN(j)], 1u);
            } else XB_SPIN(xb_ld(&bar[XB_XGEN(b.x)]) == gen, bar);
            __builtin_amdgcn_fence(__ATOMIC_ACQUIRE, "agent");
            asm volatile("s_waitcnt vmcnt(0)" ::: "memory");
        } else {
            XB_SPIN(xb_ld(&bar[XB_XGEN(b.x)]) == gen, bar);
            __builtin_amdgcn_fence(__ATOMIC_ACQUIRE, "agent");
            asm volatile("s_waitcnt vmcnt(0)" ::: "memory");
        }
    }
    __syncthreads();
}

#define XB_LSUB(j)  (3456 + 64 * (j))
#define XB_LGEN(j)  (4480 + 64 * (j))
#define XB_MISPLACED 5504
__device__ __forceinline__ void xcd_local_barrier(const XcdBarrier& b) {
    asm volatile("s_waitcnt vmcnt(0)" ::: "memory");
    __syncthreads();
    if (threadIdx.x == 0) {
        unsigned* bar = b.bar;
        __builtin_amdgcn_s_waitcnt(0);
        const unsigned nloc = b.st[0];
        const unsigned old = xb_add(&bar[XB_LSUB(b.x)], 1u);
        const unsigned gen = old / nloc;
        if (old + 1u == (gen + 1u) * nloc) (void)xb_add(&bar[XB_LGEN(b.x)], 1u);
        else XB_SPIN(xb_ld(&bar[XB_LGEN(b.x)]) == gen, bar);
        __builtin_amdgcn_fence(__ATOMIC_ACQUIRE, "agent");
        asm volatile("s_waitcnt vmcnt(0)" ::: "memory");
    }
    __syncthreads();
}

namespace pg8 {
constexpr int BM = 256, BK = 64, HALF = 128, HTB = HALF * BK * 2, STAGE_BYTES = 8 * HTB, NXCD = 8, WGM = 8;
__host__ __device__ __forceinline__ int lds_byte(int r, int c) { const int st = (r >> 4) * 2 + (c >> 5), rr = r & 15, cc = c & 31, ob = rr * 64 + cc * 2; return st * 1024 + (ob ^ (((ob >> 9) & 1) << 5)); }
__host__ __device__ __forceinline__ void stage_rc(int b, int& R, int& C) { const int st = b / 1024, sb = b % 1024, swz = sb ^ (((sb >> 9) & 1) << 5); R = (st >> 1) * 16 + swz / 64; C = (st & 1) * 32 + (swz % 64) / 2; }
__host__ __device__ __forceinline__ int perm32(int rho) { const int n = rho >> 4, i = rho & 15; return 8 * (i >> 2) + 4 * n + (i & 3); }

struct Unit { int pm, pn, orow; };
struct OrderBase {
    int nM, nN, nwg, G, c;
    __device__ void init(int nM_, int nN_, int G_, int c_) { nM = nM_; nN = nN_; nwg = nM * nN; G = G_; c = c_; }
    __device__ bool next_mn(int i, int& pm, int& pn) const {
        const long L = (long)i * G + c; if (L >= nwg) return false;
        int wgid = (int)L; { const int q = nwg / NXCD, r = nwg % NXCD, xcd = wgid % NXCD, off = wgid / NXCD; wgid = (xcd < r ? xcd * (q + 1) : r * (q + 1) + (xcd - r) * q) + off; }
        const int nig = WGM * nN, gid = wgid / nig, fm = gid * WGM, gsz = (nM - fm) < WGM ? (nM - fm) : WGM;
        pm = fm + ((wgid % nig) % gsz); pn = (wgid % nig) / gsz; return true;
    }
};
struct SchedDense : OrderBase {
    const char* A; const char* B; unsigned tstep;
    __device__ bool next(int i, Unit& u) const { if (!next_mn(i, u.pm, u.pn)) return false; u.orow = u.pm * BM; return true; }
    __device__ void addr(const Unit& u, unsigned& a, unsigned& b) const { a = (unsigned)u.pm * tstep; b = (unsigned)u.pn * tstep; }
    __device__ const int* gidx(const Unit&) const { return nullptr; }
};
struct SchedMoe : OrderBase {
    const char* A; const char* B; const int* idx; unsigned a_bstride, a_rowbytes, b_estride, b_tstep; bool gather;
    __device__ bool next(int i, Unit& u) const { if (!next_mn(i, u.pm, u.pn)) return false; const int e = u.pm >> 4, b = (u.pm >> 1) & 7, h = u.pm & 1; u.orow = (b * NE + e) * CAP + h * 256; return true; }
    __device__ void addr(const Unit& u, unsigned& a, unsigned& b) const {
        const int e = u.pm >> 4, bb = (u.pm >> 1) & 7;
        a = gather ? (unsigned)bb * a_bstride : (unsigned)u.orow * a_rowbytes;
        b = (unsigned)e * b_estride + (unsigned)u.pn * b_tstep;
    }
    __device__ const int* gidx(const Unit& u) const { return idx + u.orow; }
};

#define PG8_SA(b, h) (((b) * 2 + (h)) * HTB)
#define PG8_SB(b, h) ((4 + (b) * 2 + (h)) * HTB)
#ifndef PG8_BUFSTAGE_BF16
#define PG8_BUFSTAGE_BF16 1
#endif
#define PG8_STAGE(bufoff, rs, soff, v0, v1) do { if constexpr (FP8 || PG8_BUFSTAGE_BF16) { \
        __builtin_amdgcn_raw_ptr_buffer_load_lds(rs, (LAS void*)(lds + (bufoff) + ldsw), 16, (int)(v0), (int)(soff), 0, 0); \
        __builtin_amdgcn_raw_ptr_buffer_load_lds(rs, (LAS void*)(lds + (bufoff) + ldsw + 8192), 16, (int)(v1), (int)(soff), 0, 0); } else { \
        const char* gb_ = (&rs == &rsA ? S.A : S.B) + (soff); \
        __builtin_amdgcn_global_load_lds((const unsigned*)(gb_ + (v0)), (LAS unsigned*)(lds + (bufoff) + ldsw), 16, 0, 0); \
        __builtin_amdgcn_global_load_lds((const unsigned*)(gb_ + (v1)), (LAS unsigned*)(lds + (bufoff) + ldsw + 8192), 16, 0, 0); } } while (0)
#define PG8_LDA(dst, b, h) do { if constexpr (FP8) { _Pragma("unroll") for (int m = 0; m < 4; ++m) dst##8[m] = cat8(*(const LAS bf16x8*)(lds + PG8_SA(b, h) + aoff + m * 2048), *(const LAS bf16x8*)(lds + PG8_SA(b, h) + aoff + m * 2048 + 1024)); } \
    else { _Pragma("unroll") for (int m = 0; m < 4; ++m) _Pragma("unroll") for (int k = 0; k < 2; ++k) dst[m][k] = *(const LAS bf16x8*)(lds + PG8_SA(b, h) + aoff + m * 2048 + k * 1024); } } while (0)
#define PG8_LDB(dst, b, h) do { if constexpr (FP8) { _Pragma("unroll") for (int n = 0; n < 2; ++n) dst##8[n] = cat8(*(const LAS bf16x8*)(lds + PG8_SB(b, h) + boff + n * 2048), *(const LAS bf16x8*)(lds + PG8_SB(b, h) + boff + n * 2048 + 1024)); } \
    else { _Pragma("unroll") for (int n = 0; n < 2; ++n) _Pragma("unroll") for (int k = 0; k < 2; ++k) dst[n][k] = *(const LAS bf16x8*)(lds + PG8_SB(b, h) + boff + n * 2048 + k * 1024); } } while (0)
typedef int i32x4 __attribute__((ext_vector_type(4)));
typedef int i32x8 __attribute__((ext_vector_type(8)));
__device__ __forceinline__ i32x8 cat8(bf16x8 lo, bf16x8 hi) { const i32x4 a = __builtin_bit_cast(i32x4, lo), b = __builtin_bit_cast(i32x4, hi); return __builtin_shufflevector(a, b, 0, 1, 2, 3, 4, 5, 6, 7); }
#define PG8_MMA(ai, bj, At, Bt) do { __builtin_amdgcn_s_setprio(1); \
    if constexpr (FP8) { _Pragma("unroll") for (int m = 0; m < 4; ++m) _Pragma("unroll") for (int n = 0; n < 2; ++n) \
        acc[ai][bj][m][n] = __builtin_amdgcn_mfma_scale_f32_16x16x128_f8f6f4(Bt##8[n], At##8[m], acc[ai][bj][m][n], 0, 0, 0, 0x7f7f7f7f, 0, 0x7f7f7f7f); } \
    else { _Pragma("unroll") for (int m = 0; m < 4; ++m) _Pragma("unroll") for (int n = 0; n < 2; ++n) _Pragma("unroll") for (int k = 0; k < 2; ++k) \
        acc[ai][bj][m][n] = __builtin_amdgcn_mfma_f32_16x16x32_bf16(Bt[n][k], At[m][k], acc[ai][bj][m][n], 0, 0, 0); } __builtin_amdgcn_s_setprio(0); } while (0)
#define PG8_WAIT_V(n) asm volatile("s_waitcnt vmcnt(" #n ")" ::: "memory")
#define PG8_WAIT_L(n) asm volatile("s_waitcnt lgkmcnt(" #n ")" ::: "memory")
#define PG8_BAR __builtin_amdgcn_s_barrier()
#define PG8_SCHED __builtin_amdgcn_sched_barrier(0)

template <class Epi, class Sched, bool ALIGN_EPI, bool GATHER, bool MIDHOOK, bool FP8 = false>
__device__ __forceinline__ void gemm_phase(LAS unsigned char* lds, const int RB, const Sched& S, const Epi& E) {
    const int tid = tid_l(), wid = __builtin_amdgcn_readfirstlane(tid >> 6), lane = tid & 63, wr = wid >> 2, wc = wid & 3, fr = lane & 15, fq = lane >> 4;
    const int nt = RB / (BK * 2);
    int Rs[2], Cs[2];
    unsigned voffB0, voffB1, vA[2][2], nvA[2][2];
#pragma unroll
    for (int i = 0; i < 2; ++i) stage_rc(tid * 16 + i * 8192, Rs[i], Cs[i]);
    { const int Rb0 = Epi::PERM ? ((Rs[0] & ~31) + perm32(Rs[0] & 31)) : Rs[0], Rb1 = Epi::PERM ? ((Rs[1] & ~31) + perm32(Rs[1] & 31)) : Rs[1];
      voffB0 = (unsigned)(Rb0 * RB + Cs[0] * 2); voffB1 = (unsigned)(Rb1 * RB + Cs[1] * 2); }
    const unsigned kstep = (unsigned)(BK * 2);
    const unsigned hstep = (unsigned)(HALF * RB);
    const auto rsA = __builtin_amdgcn_make_buffer_rsrc((void*)S.A, (short)0, 0x7ffffff0, 0x00020000), rsB = __builtin_amdgcn_make_buffer_rsrc((void*)S.B, (short)0, 0x7ffffff0, 0x00020000);
    const unsigned ldsw = (unsigned)wid * 1024u;
    const int aoff = lds_byte(wr * 64 + fr, fq * 8), boff = lds_byte(wc * 32 + fr, fq * 8);
    Unit cur, nxt; int ui = 0;
    if (!S.next(0, cur)) return;
    f32x4 acc[2][2][4][2];
#pragma unroll
    for (int a = 0; a < 2; ++a)
#pragma unroll
        for (int b = 0; b < 2; ++b)
#pragma unroll
            for (int m = 0; m < 4; ++m)
#pragma unroll
                for (int n = 0; n < 2; ++n) acc[a][b][m][n] = (f32x4){0.f, 0.f, 0.f, 0.f};
    bf16x8 At[4][2], B0[2][2], B1[2][2]; i32x8 At8[4], B08[2], B18[2];
    unsigned cA, cB; S.addr(cur, cA, cB);
    if constexpr (GATHER) { const int* gi = S.gidx(cur);
#pragma unroll
        for (int h = 0; h < 2; ++h)
#pragma unroll
            for (int i = 0; i < 2; ++i) vA[h][i] = (unsigned)(gi[h * HALF + Rs[i]] * RB + Cs[i] * 2);
    } else {
#pragma unroll
        for (int h = 0; h < 2; ++h)
#pragma unroll
            for (int i = 0; i < 2; ++i) vA[h][i] = (unsigned)((h * HALF + Rs[i]) * RB + Cs[i] * 2);
    }
    PG8_STAGE(PG8_SB(0, 0), rsB, cB, voffB0, voffB1); PG8_STAGE(PG8_SB(0, 1), rsB, cB + hstep, voffB0, voffB1); PG8_STAGE(PG8_SA(0, 0), rsA, cA, vA[0][0], vA[0][1]); PG8_STAGE(PG8_SA(0, 1), rsA, cA + (GATHER ? 0u : hstep), vA[GATHER ? 1 : 0][0], vA[GATHER ? 1 : 0][1]);
    if (wr == 1) PG8_BAR;
    PG8_WAIT_V(2); PG8_BAR;
    PG8_STAGE(PG8_SB(1, 0), rsB, cB + kstep, voffB0, voffB1); PG8_STAGE(PG8_SA(1, 0), rsA, cA + kstep, vA[0][0], vA[0][1]); PG8_STAGE(PG8_SB(1, 1), rsB, cB + hstep + kstep, voffB0, voffB1);
    PG8_WAIT_V(6); PG8_BAR;
    for (;;) {
        const bool has_next = S.next(ui + 1, nxt);
        unsigned nA = cA, nB = cB;
        if (has_next) S.addr(nxt, nA, nB);
        if constexpr (GATHER) {
            if (has_next) { const int* gi = S.gidx(nxt);
#pragma unroll
                for (int h = 0; h < 2; ++h)
#pragma unroll
                    for (int i = 0; i < 2; ++i) nvA[h][i] = (unsigned)(gi[h * HALF + Rs[i]] * RB + Cs[i] * 2);
            } else {
#pragma unroll
                for (int h = 0; h < 2; ++h)
#pragma unroll
                    for (int i = 0; i < 2; ++i) nvA[h][i] = vA[h][i];
            }
        }
#pragma unroll (FP8 ? 1 : 2)
        for (int t = 0; t < nt; t += 2) {
            const bool last = (t == nt - 2);
            const unsigned a1 = cA + (unsigned)(t + 1) * kstep;
            const unsigned a2 = last ? nA : cA + (unsigned)(t + 2) * kstep, b2 = last ? nB : cB + (unsigned)(t + 2) * kstep;
            const unsigned a3 = a2 + kstep, b3 = b2 + kstep;
            if constexpr (MIDHOOK) { if (t == nt / 2) E.mid(acc, cur, wr, wc, fr, fq); }
            PG8_LDB(B0, 0, 0); PG8_LDB(B1, 0, 1); PG8_SCHED; PG8_LDA(At, 0, 0); PG8_STAGE(PG8_SA(1, 1), rsA, a1 + (GATHER ? 0u : hstep), vA[GATHER ? 1 : 0][0], vA[GATHER ? 1 : 0][1]);
            PG8_WAIT_V(8); PG8_WAIT_L(0); PG8_BAR; PG8_MMA(0, 0, At, B0); PG8_MMA(0, 1, At, B1); PG8_BAR; PG8_SCHED;
            if constexpr (GATHER) { if (last) {
#pragma unroll
                for (int h = 0; h < 2; ++h)
#pragma unroll
                    for (int i = 0; i < 2; ++i) vA[h][i] = nvA[h][i]; } }
            PG8_LDA(At, 0, 1); PG8_STAGE(PG8_SB(0, 0), rsB, b2, voffB0, voffB1); PG8_STAGE(PG8_SB(0, 1), rsB, b2 + hstep, voffB0, voffB1); PG8_STAGE(PG8_SA(0, 0), rsA, a2, vA[0][0], vA[0][1]);
            PG8_WAIT_V(8); PG8_WAIT_L(0); PG8_BAR; PG8_MMA(1, 0, At, B0); PG8_MMA(1, 1, At, B1); PG8_BAR; PG8_SCHED;
            PG8_LDB(B0, 1, 0); PG8_LDB(B1, 1, 1); PG8_SCHED; PG8_LDA(At, 1, 0); PG8_STAGE(PG8_SA(0, 1), rsA, a2 + (GATHER ? 0u : hstep), vA[GATHER ? 1 : 0][0], vA[GATHER ? 1 : 0][1]);
            PG8_WAIT_V(8); PG8_WAIT_L(0); PG8_BAR; PG8_MMA(0, 0, At, B0); PG8_MMA(0, 1, At, B1); PG8_BAR; PG8_SCHED;
            PG8_LDA(At, 1, 1); PG8_STAGE(PG8_SB(1, 0), rsB, b3, voffB0, voffB1); PG8_STAGE(PG8_SB(1, 1), rsB, b3 + hstep, voffB0, voffB1); PG8_STAGE(PG8_SA(1, 0), rsA, a3, vA[0][0], vA[0][1]);
            PG8_WAIT_V(8); PG8_WAIT_L(0); PG8_BAR; PG8_MMA(1, 0, At, B0); PG8_MMA(1, 1, At, B1); PG8_BAR; PG8_SCHED;
        }
        if constexpr (ALIGN_EPI) { if (wr == 0) PG8_BAR; }
        E(acc, cur, wr, wc, fr, fq);
        if (!has_next) break;
#pragma unroll
        for (int a = 0; a < 2; ++a)
#pragma unroll
            for (int b = 0; b < 2; ++b)
#pragma unroll
                for (int m = 0; m < 4; ++m)
#pragma unroll
                    for (int n = 0; n < 2; ++n) acc[a][b][m][n] = (f32x4){0.f, 0.f, 0.f, 0.f};
        cur = nxt; cA = nA; cB = nB; ++ui;
        if constexpr (GATHER) {
#pragma unroll
            for (int h = 0; h < 2; ++h)
#pragma unroll
                for (int i = 0; i < 2; ++i) vA[h][i] = nvA[h][i];
        }
        if constexpr (ALIGN_EPI) { if (wr == 1) PG8_BAR; }
    }
    PG8_WAIT_V(0);
    if constexpr (!ALIGN_EPI) { if (wr == 0) PG8_BAR; }
    PG8_BAR;
}

template <class Epi, class Sched, bool GATHER, bool MIDHOOK>
__device__ __forceinline__ void gemm_phase_naive(const int K, const Sched& S, const Epi& E) {
    const int tid = tid_l(), wid = tid >> 6, lane = tid & 63, wr = wid >> 2, wc = wid & 3, fr = lane & 15, fq = lane >> 4;
    Unit u;
    for (int i = 0; S.next(i, u); ++i) {
        unsigned ao_, bo_; S.addr(u, ao_, bo_); const char* A = S.A + ao_; const char* B = S.B + bo_; const int* gi = S.gidx(u);
        f32x4 acc[2][2][4][2];
#pragma unroll
        for (int a = 0; a < 2; ++a)
#pragma unroll
            for (int b = 0; b < 2; ++b)
#pragma unroll
                for (int m = 0; m < 4; ++m)
#pragma unroll
                    for (int n = 0; n < 2; ++n) acc[a][b][m][n] = (f32x4){0.f, 0.f, 0.f, 0.f};
        for (int half = 0; half < (MIDHOOK ? 2 : 1); ++half) {
            const int k_lo = MIDHOOK ? half * (K / 2) : 0, k_hi = MIDHOOK ? (half + 1) * (K / 2) : K;
            if (MIDHOOK && half == 1) E.mid(acc, u, wr, wc, fr, fq);
#pragma unroll
            for (int ai = 0; ai < 2; ++ai)
#pragma unroll
                for (int m = 0; m < 4; ++m) {
                    const int rloc = 128 * ai + 64 * wr + 16 * m + fr;
                    const int arow = GATHER ? gi[rloc] : rloc;
                    const bf16_t* ap = (const bf16_t*)A + (size_t)arow * K;
#pragma unroll
                    for (int bj = 0; bj < 2; ++bj)
#pragma unroll
                        for (int n = 0; n < 2; ++n)
#pragma unroll
                            for (int j = 0; j < 4; ++j) {
                                const int cloc = 128 * bj + 32 * wc + (Epi::PERM ? 8 * fq + 4 * n + j : 16 * n + 4 * fq + j);
                                const bf16_t* bp = (const bf16_t*)B + (size_t)cloc * K;
                                float s = 0.f;
                                for (int k = k_lo; k < k_hi; k += 8) {
                                    const u32x4 av = *(const u32x4*)(ap + k), bv = *(const u32x4*)(bp + k);
                                    s += bflo(av.x) * bflo(bv.x) + bfhi(av.x) * bfhi(bv.x) + bflo(av.y) * bflo(bv.y) + bfhi(av.y) * bfhi(bv.y)
                                       + bflo(av.z) * bflo(bv.z) + bfhi(av.z) * bfhi(bv.z) + bflo(av.w) * bflo(bv.w) + bfhi(av.w) * bfhi(bv.w);
                                }
                                acc[ai][bj][m][n][j] += s;
                            }
                }
        }
        E(acc, u, wr, wc, fr, fq);
    }
}

struct EpiProj {
    static constexpr bool PERM = true;
    bf16_t* qkvus; bf16_t* gates; const float* b_gate; float* kn2;
    __device__ __forceinline__ void operator()(const f32x4 (&acc)[2][2][4][2], const Unit& u, int wr, int wc, int fr, int fq) const {
        const int pn = u.pn, row0 = u.orow + wr * 64 + fr;
        bf16_t* base; int ldc, mode, colt;
        if (pn < 10) { const int which = pn >> 1; base = qkvus + (size_t)which * ((size_t)MTOK * 512); ldc = 512; colt = (pn & 1) * 256; mode = which == 0 ? 0 : (which < 3 ? 1 : 2); }
        else { base = gates; ldc = 2048; colt = (pn - 10) * 256; mode = 3; }
        const int col0 = colt + wc * 32 + 8 * fq;
        f32x4 bv[2][2];
#pragma unroll
        for (int bj = 0; bj < 2; ++bj)
#pragma unroll
            for (int n = 0; n < 2; ++n) bv[bj][n] = (mode == 3) ? *(const f32x4*)(b_gate + col0 + bj * HALF + 4 * n) : (f32x4){0.f, 0.f, 0.f, 0.f};
#pragma unroll
        for (int ai = 0; ai < 2; ++ai)
#pragma unroll
            for (int m = 0; m < 4; ++m) { bf16_t* rowp = base + (size_t)(row0 + ai * HALF + m * 16) * ldc + col0;
#pragma unroll
                for (int bj = 0; bj < 2; ++bj) { f32x4 v0 = acc[ai][bj][m][0] + bv[bj][0], v1 = acc[ai][bj][m][1] + bv[bj][1];
                    if (mode == 0) { v0 = v0 * C2; v1 = v1 * C2; }
                    else if (mode == 2) gelu8(v0, v1);
                    else if (mode == 3) {
#pragma unroll
                        for (int j = 0; j < 4; ++j) { v0[j] = sigmoidf_(v0[j]); v1[j] = sigmoidf_(v1[j]); } }
                    u32x4 w; w.x = cvt_pk_bf16(v0[0], v0[1]); w.y = cvt_pk_bf16(v0[2], v0[3]); w.z = cvt_pk_bf16(v1[0], v1[1]); w.w = cvt_pk_bf16(v1[2], v1[3]);
                    *(u32x4*)(rowp + bj * HALF) = w;
                    if (pn == 2 || pn == 3) {
                        float ssq = bflo(w.x) * bflo(w.x); ssq = fmaf(bfhi(w.x), bfhi(w.x), ssq); ssq = fmaf(bflo(w.y), bflo(w.y), ssq); ssq = fmaf(bfhi(w.y), bfhi(w.y), ssq);
                        ssq = fmaf(bflo(w.z), bflo(w.z), ssq); ssq = fmaf(bfhi(w.z), bfhi(w.z), ssq); ssq = fmaf(bflo(w.w), bflo(w.w), ssq); ssq = fmaf(bfhi(w.w), bfhi(w.w), ssq);
                        ssq += swz_xor<16>(ssq);
                        { auto rr = __builtin_amdgcn_permlane32_swap(__float_as_uint(ssq), __float_as_uint(ssq), false, false); ssq = __uint_as_float(rr[0]) + __uint_as_float(rr[1]); }
                        if (fq == 0) atomicAdd(kn2 + (size_t)(row0 + ai * HALF + m * 16) * 8 + (pn - 2) * 4 + 2 * bj + (wc >> 1), ssq); }
                } }
    }
};
struct EpiGate {
    static constexpr bool PERM = true;
    bf16_t* gates; const float* b_gate;
    __device__ __forceinline__ void operator()(const f32x4 (&acc)[2][2][4][2], const Unit& u, int wr, int wc, int fr, int fq) const {
        const int row0 = u.orow + wr * 64 + fr, col0 = u.pn * BM + wc * 32 + 8 * fq; constexpr float SI = 1.f / (MOE_WSCALE * MOE_HSCALE);
        f32x4 bv[2][2];
#pragma unroll
        for (int bj = 0; bj < 2; ++bj)
#pragma unroll
            for (int n = 0; n < 2; ++n) bv[bj][n] = *(const f32x4*)(b_gate + col0 + bj * HALF + 4 * n) * (-LOG2E);
#pragma unroll
        for (int ai = 0; ai < 2; ++ai)
#pragma unroll
            for (int m = 0; m < 4; ++m) { bf16_t* rowp = gates + (size_t)(row0 + ai * HALF + m * 16) * 2048 + col0;
#pragma unroll
                for (int bj = 0; bj < 2; ++bj) { f32x4 v0, v1;
#pragma unroll
                    for (int j = 0; j < 4; ++j) { v0[j] = __builtin_amdgcn_rcpf(1.f + __builtin_amdgcn_exp2f(fmaf(acc[ai][bj][m][0][j], -LOG2E * SI, bv[bj][0][j])));
                                                  v1[j] = __builtin_amdgcn_rcpf(1.f + __builtin_amdgcn_exp2f(fmaf(acc[ai][bj][m][1][j], -LOG2E * SI, bv[bj][1][j]))); }
                    u32x4 w; w.x = cvt_pk_bf16(v0[0], v0[1]); w.y = cvt_pk_bf16(v0[2], v0[3]); w.z = cvt_pk_bf16(v1[0], v1[1]); w.w = cvt_pk_bf16(v1[2], v1[3]);
                    *(u32x4*)(rowp + bj * HALF) = w; } }
    }
};
struct EpiMix {
    static constexpr bool PERM = true;
    const bf16_t* gates; bf16_t* mixed;
    __device__ __forceinline__ void mid(f32x4 (&acc)[2][2][4][2], const Unit& u, int, int, int, int) const {
        int t_ = threadIdx.x; asm volatile("" : "+v"(t_));
        const int wid_ = t_ >> 6, wr = wid_ >> 2, wc = wid_ & 3, fr = t_ & 15, fq = (t_ & 63) >> 4;
        const int row0 = u.orow + wr * 64 + fr, col0 = u.pn * BM + wc * 32 + 8 * fq;
#pragma unroll
        for (int ai = 0; ai < 2; ++ai)
#pragma unroll
            for (int m = 0; m < 4; ++m) { const bf16_t* gp = gates + (size_t)(row0 + ai * HALF + m * 16) * 2048 + col0; asm volatile("" : "+v"(gp));
#pragma unroll
                for (int bj = 0; bj < 2; ++bj) { const u32x4 ga = *(const u32x4*)(gp + bj * HALF), gb = *(const u32x4*)(gp + 1024 + bj * HALF);
                    f32x4 r0, r1;
                    r0[0] = bflo(ga.x) * __builtin_amdgcn_rcpf(bflo(gb.x)); r0[1] = bfhi(ga.x) * __builtin_amdgcn_rcpf(bfhi(gb.x)); r0[2] = bflo(ga.y) * __builtin_amdgcn_rcpf(bflo(gb.y)); r0[3] = bfhi(ga.y) * __builtin_amdgcn_rcpf(bfhi(gb.y));
                    r1[0] = bflo(ga.z) * __builtin_amdgcn_rcpf(bflo(gb.z)); r1[1] = bfhi(ga.z) * __builtin_amdgcn_rcpf(bfhi(gb.z)); r1[2] = bflo(ga.w) * __builtin_amdgcn_rcpf(bflo(gb.w)); r1[3] = bfhi(ga.w) * __builtin_amdgcn_rcpf(bfhi(gb.w));
                    acc[ai][bj][m][0] = acc[ai][bj][m][0] * r0; acc[ai][bj][m][1] = acc[ai][bj][m][1] * r1; } }
    }
    __device__ __forceinline__ void operator()(const f32x4 (&acc)[2][2][4][2], const Unit& u, int wr, int wc, int fr, int fq) const {
        const int row0 = u.orow + wr * 64 + fr, col0 = u.pn * BM + wc * 32 + 8 * fq;
#pragma unroll
        for (int ai = 0; ai < 2; ++ai)
#pragma unroll
            for (int m = 0; m < 4; ++m) { const size_t r = (size_t)(row0 + ai * HALF + m * 16);
#pragma unroll
                for (int bj = 0; bj < 2; ++bj) { const u32x4 gb = *(const u32x4*)(gates + r * 2048 + 1024 + col0 + bj * HALF);
                    const f32x4 v0 = acc[ai][bj][m][0], v1 = acc[ai][bj][m][1];
                    u32x4 w; w.x = cvt_pk_bf16(v0[0] * bflo(gb.x), v0[1] * bfhi(gb.x)); w.y = cvt_pk_bf16(v0[2] * bflo(gb.y), v0[3] * bfhi(gb.y));
                    w.z = cvt_pk_bf16(v1[0] * bflo(gb.z), v1[1] * bfhi(gb.z)); w.w = cvt_pk_bf16(v1[2] * bflo(gb.w), v1[3] * bfhi(gb.w));
                    *(u32x4*)(mixed + r * 1024 + col0 + bj * HALF) = w; } }
    }
};
struct EpiRes {
    static constexpr bool PERM = true;
    const float* x; bf16_t* out;
    __device__ __forceinline__ void operator()(const f32x4 (&acc)[2][2][4][2], const Unit& u, int wr, int wc, int fr, int fq) const {
        const int row0 = u.orow + wr * 64 + fr, col0 = u.pn * BM + wc * 32 + 8 * fq;
#pragma unroll
        for (int ai = 0; ai < 2; ++ai)
#pragma unroll
            for (int m = 0; m < 4; ++m) { const size_t off = (size_t)(row0 + ai * HALF + m * 16) * DM + col0;
#pragma unroll
                for (int bj = 0; bj < 2; ++bj) { const f32x4 b0 = *(const f32x4*)(x + off + bj * HALF), b1 = *(const f32x4*)(x + off + bj * HALF + 4);
                    const f32x4 v0 = b0 + acc[ai][bj][m][0], v1 = b1 + acc[ai][bj][m][1];
                    u32x4 w; w.x = cvt_pk_bf16(v0[0], v0[1]); w.y = cvt_pk_bf16(v0[2], v0[3]); w.z = cvt_pk_bf16(v1[0], v1[1]); w.w = cvt_pk_bf16(v1[2], v1[3]);
                    *(u32x4*)(out + off + bj * HALF) = w; } }
    }
};
struct EpiSwiglu {
    static constexpr bool PERM = true;
    unsigned char* act;
    __device__ __forceinline__ void operator()(const f32x4 (&acc)[2][2][4][2], const Unit& u, int, int, int, int) const {
        const int t_ = tid_l(), wid_ = t_ >> 6, wr = wid_ >> 2, wc = wid_ & 3, fr = t_ & 15, fq = (t_ & 63) >> 4;
        const int row0 = u.orow + wr * 64 + fr, col0 = u.pn * HALF + wc * 32 + 8 * fq;
#pragma unroll
        for (int ai = 0; ai < 2; ++ai)
#pragma unroll
            for (int m = 0; m < 4; ++m) {
                f32x4 o0, o1; constexpr float SI = 1.f / (MOE_WSCALE * MOE_HSCALE), IKK = 1.f / (SI * SI * MOE_ASCALE), CE = -LOG2E * SI;
#pragma unroll
                for (int j = 0; j < 4; ++j) {
                    const float g0 = acc[ai][0][m][0][j], g1 = acc[ai][0][m][1][j];
                    const float e0 = __builtin_amdgcn_exp2f(g0 * CE), e1 = __builtin_amdgcn_exp2f(g1 * CE);
                    o0[j] = (g0 * acc[ai][1][m][0][j]) * __builtin_amdgcn_rcpf(fmaf(e0, IKK, IKK));
                    o1[j] = (g1 * acc[ai][1][m][1][j]) * __builtin_amdgcn_rcpf(fmaf(e1, IKK, IKK)); }
                int w0 = 0, w1 = 0;
                w0 = __builtin_amdgcn_cvt_pk_fp8_f32(o0[0], o0[1], w0, false); w0 = __builtin_amdgcn_cvt_pk_fp8_f32(o0[2], o0[3], w0, true);
                w1 = __builtin_amdgcn_cvt_pk_fp8_f32(o1[0], o1[1], w1, false); w1 = __builtin_amdgcn_cvt_pk_fp8_f32(o1[2], o1[3], w1, true);
                u32x2 w; w.x = (unsigned)w0; w.y = (unsigned)w1;
                *(u32x2*)(act + (size_t)(row0 + ai * HALF + m * 16) * FF + col0) = w; }
    }
};
struct EpiDown {
    static constexpr bool PERM = true;
    const float* gv; unsigned char* y;
    __device__ __forceinline__ void operator()(const f32x4 (&acc)[2][2][4][2], const Unit& u, int, int, int, int) const {
        const int t_ = tid_l(), wid_ = t_ >> 6, wr = wid_ >> 2, wc = wid_ & 3, fr = t_ & 15, fq = (t_ & 63) >> 4;
        const int row0 = u.orow + wr * 64 + fr, col0 = u.pn * BM + wc * 32 + 8 * fq;
#pragma unroll
        for (int ai = 0; ai < 2; ++ai)
#pragma unroll
            for (int m = 0; m < 4; ++m) { const int r = row0 + ai * HALF + m * 16; const float g = gv[r] * (MOE_YSCALE / (MOE_WSCALE * MOE_ASCALE));
#pragma unroll
                for (int bj = 0; bj < 2; ++bj) { const f32x4 v0 = acc[ai][bj][m][0] * g, v1 = acc[ai][bj][m][1] * g;
                    int w0 = 0, w1 = 0;
                    w0 = __builtin_amdgcn_cvt_pk_fp8_f32(v0[0], v0[1], w0, false); w0 = __builtin_amdgcn_cvt_pk_fp8_f32(v0[2], v0[3], w0, true);
                    w1 = __builtin_amdgcn_cvt_pk_fp8_f32(v1[0], v1[1], w1, false); w1 = __builtin_amdgcn_cvt_pk_fp8_f32(v1[2], v1[3], w1, true);
                    u32x2 w; w.x = (unsigned)w0; w.y = (unsigned)w1;
                    *(u32x2*)(y + (size_t)r * DM + col0 + bj * HALF) = w; } }
    }
};
}

struct Args { const float* in[22]; float* out; unsigned char* ws; int ph_lo, ph_hi; };
struct Frame {
    LAS unsigned char* lds; unsigned char* ldsg;
    int tid, lane, wave, vcu, G;
    const float* in[22]; float* out; unsigned char* ws;
};

__device__ __forceinline__ unsigned pk2(float lo, float hi) { return cvt_pk_bf16(lo, hi); }
__device__ __forceinline__ void p0_transpose_item(const float* __restrict__ W, int K, int N, bf16_t* WT, int dst_row, int k0, int n0, LAS float* scr, int lane) {
#pragma unroll 8
    for (int i = 0; i < 32; ++i) { const int kk = 2 * i + (lane >> 5); scr[kk * 33 + (lane & 31)] = W[(size_t)(k0 + kk) * N + n0 + (lane & 31)]; }
    LDS_WAIT(); asm volatile("" ::: "memory");
    const int c = lane & 7;
#pragma unroll
    for (int j = 0; j < 4; ++j) { const int n = (lane >> 3) + 8 * j; const LAS float* s = scr + (8 * c) * 33 + n;
        u32x4 o; o.x = pk2(s[0 * 33], s[1 * 33]); o.y = pk2(s[2 * 33], s[3 * 33]); o.z = pk2(s[4 * 33], s[5 * 33]); o.w = pk2(s[6 * 33], s[7 * 33]);
        *(u32x4*)(WT + (size_t)(dst_row + n) * K + k0 + 8 * c) = o; }
    LDS_WAIT(); asm volatile("" ::: "memory");
}
__device__ __forceinline__ void p0_transpose_item_fp8(const float* __restrict__ W, int K, int N, unsigned char* WT, int dst_row, int k0, int n0, LAS float* scr, int lane) {
#pragma unroll 8
    for (int i = 0; i < 32; ++i) { const int kk = 2 * i + (lane >> 5); scr[kk * 33 + (lane & 31)] = W[(size_t)(k0 + kk) * N + n0 + (lane & 31)]; }
    LDS_WAIT(); asm volatile("" ::: "memory");
    const int c = lane & 7;
#pragma unroll
    for (int j = 0; j < 4; ++j) { const int n = (lane >> 3) + 8 * j; const LAS float* s = scr + (8 * c) * 33 + n;
        int w0 = 0, w1 = 0;
        w0 = __builtin_amdgcn_cvt_pk_fp8_f32(s[0 * 33] * MOE_WSCALE, s[1 * 33] * MOE_WSCALE, w0, false); w0 = __builtin_amdgcn_cvt_pk_fp8_f32(s[2 * 33] * MOE_WSCALE, s[3 * 33] * MOE_WSCALE, w0, true);
        w1 = __builtin_amdgcn_cvt_pk_fp8_f32(s[4 * 33] * MOE_WSCALE, s[5 * 33] * MOE_WSCALE, w1, false); w1 = __builtin_amdgcn_cvt_pk_fp8_f32(s[6 * 33] * MOE_WSCALE, s[7 * 33] * MOE_WSCALE, w1, true);
        u32x2 o; o.x = (unsigned)w0; o.y = (unsigned)w1;
        *(u32x2*)(WT + (size_t)(dst_row + n) * K + k0 + 8 * c) = o; }
    LDS_WAIT(); asm volatile("" ::: "memory");
}
constexpr int EXP_ITEMS = 3 * 16384;
#ifndef EXP_P2_ITEMS
#define EXP_P2_ITEMS 24576
#endif
#ifndef EXP_P6_ITEMS
#define EXP_P6_ITEMS 8192
#endif
__device__ __forceinline__ void expert_item(Frame& F, int r, LAS float* scr) {
    unsigned char* Wgu = (unsigned char*)(F.ws + WS_WGU); unsigned char* Wd = (unsigned char*)(F.ws + WS_WD);
    const int seg = r / 16384, q = r % 16384, e = q / 1024, t = q % 1024;
    if (seg < 2) { const int kb = t / 64, nb = t % 64, n0 = 32 * nb;
        p0_transpose_item_fp8((seg == 0 ? F.in[18] : F.in[19]) + (size_t)e * 1024 * 2048, 1024, 2048, Wgu + (size_t)e * 4096 * 1024, (n0 >> 7) * 256 + (n0 & 127) + seg * 128, 64 * kb, n0, scr, F.lane); }
    else { const int kb = t / 32, nb = t % 32;
        p0_transpose_item_fp8(F.in[20] + (size_t)e * 2048 * 1024, 2048, 1024, Wd + (size_t)e * 1024 * 2048, 32 * nb, 64 * kb, 32 * nb, scr, F.lane); }
}
__device__ __forceinline__ void p0_prologue(Frame& F) {
    LAS float* scr = (LAS float*)(F.lds + F.wave * 16384);
    const int gw = F.vcu * NWAVES + F.wave, NGW = F.G * NWAVES;
    bf16_t* Wcat = (bf16_t*)(F.ws + WS_WCAT); bf16_t* Wbr = (bf16_t*)(F.ws + WS_WBR); bf16_t* Wout = (bf16_t*)(F.ws + WS_WOUT);
    constexpr int I0 = 16 * 80, I1 = I0 + 16 * 64, I2 = I1 + 16 * 32, I3 = I2 + 16 * 32, NITEMS = I3 + EXP_ITEMS - (EXP_P2_ITEMS + EXP_P6_ITEMS);
    for (int it = gw; it < NITEMS; it += NGW) {
        if (it < I0) { const int kb = it / 80, nb = it % 80; p0_transpose_item(F.in[2], 1024, 2560, Wcat, 32 * nb, 64 * kb, 32 * nb, scr, F.lane); }
        else if (it < I1) { const int r = it - I0, kb = r / 64, nb = r % 64; p0_transpose_item_fp8(F.in[3], 1024, 2048, (unsigned char*)(F.ws + WS_WG8), 32 * nb, 64 * kb, 32 * nb, scr, F.lane); }
        else if (it < I2) { const int r = it - I1, kb = r / 32, nb = r % 32; p0_transpose_item(F.in[14], 1024, 1024, Wbr, 32 * nb, 64 * kb, 32 * nb, scr, F.lane); }
        else if (it < I3) { const int r = it - I2, kb = r / 32, nb = r % 32; p0_transpose_item(F.in[15], 1024, 1024, Wout, 32 * nb, 64 * kb, 32 * nb, scr, F.lane); }
        else expert_item(F, it - I3 + (EXP_P2_ITEMS + EXP_P6_ITEMS), scr);
    }
    { f32x4* z = (f32x4*)(F.ws + WS_KN2); const int gt = F.vcu * NTHREADS + F.tid; for (int i = gt; i < MTOK * 8 / 4; i += F.G * NTHREADS) z[i] = (f32x4){0.f, 0.f, 0.f, 0.f}; }
    { bf16_t* Ws = (bf16_t*)(F.ws + WS_WSGU); const int gt = F.vcu * NTHREADS + F.tid;
      for (int i = gt; i < 65536 / 8; i += F.G * NTHREADS) { const f32x4 a = *(const f32x4*)(F.in[12] + i * 8), b = *(const f32x4*)(F.in[12] + i * 8 + 4);
          u32x4 o; o.x = pk2(a[0], a[1]); o.y = pk2(a[2], a[3]); o.z = pk2(b[0], b[1]); o.w = pk2(b[2], b[3]); *(u32x4*)(Ws + i * 8) = o; } }
    bf16_t* XN = (bf16_t*)((unsigned char*)F.out + DO_XN);
    const float* g = F.in[1];
    f32x4 gg[4];
#pragma unroll
    for (int j = 0; j < 4; ++j) gg[j] = *(const f32x4*)(g + (F.lane + 64 * j) * 4);
    for (int m = gw; m < MTOK; m += NGW) {
        const f32x4* xr = (const f32x4*)(F.in[0] + (size_t)m * DM) + F.lane;
        f32x4 v[4]; float s = 0.f;
#pragma unroll
        for (int j = 0; j < 4; ++j) { v[j] = xr[64 * j]; s += (v[j].x * v[j].x + v[j].y * v[j].y) + (v[j].z * v[j].z + v[j].w * v[j].w); }
        const float r = rsqrtf(wave_sum(s) * (1.f / DM) + EPS);
        u32x2* o8 = (u32x2*)(XN + (size_t)m * DM) + F.lane; int* o4 = (int*)((unsigned char*)F.out + DO_XN8 + (size_t)m * DM) + F.lane;
#pragma unroll
        for (int j = 0; j < 4; ++j) { const f32x4 h = {v[j].x * r * gg[j].x, v[j].y * r * gg[j].y, v[j].z * r * gg[j].z, v[j].w * r * gg[j].w};
            u32x2 w; w.x = pk2(h.x, h.y); w.y = pk2(h.z, h.w); o8[64 * j] = w;
            int p8 = 0; p8 = __builtin_amdgcn_cvt_pk_fp8_f32(h.x * MOE_HSCALE, h.y * MOE_HSCALE, p8, false); p8 = __builtin_amdgcn_cvt_pk_fp8_f32(h.z * MOE_HSCALE, h.w * MOE_HSCALE, p8, true); o4[64 * j] = p8; }
    }
}

namespace att {
constexpr int KVBLK = 64, QBLK = 32, NT = SEQ / KVBLK;
constexpr int SHM_V = 64 * 128 * 2, SHM_K = 64 * 64 * 2;
constexpr int NSLOT = 3, OFF_K = 0, OFF_V = NSLOT * SHM_K, OFF_WS = NSLOT * (SHM_K + SHM_V), OFF_NRM = OFF_WS + 2048, OFF_OST = OFF_NRM + 2048;
static_assert(OFF_OST + 8 * 8192 <= LDSCTL_OFF, "attention LDS map");
constexpr int OFF_OST_COMMENT = 0;
constexpr float THR2 = 8.f;
#define KSWZ64(row, colB) ((row) * 128 + ((colB) ^ ((((row) >> 1) & 7) << 4)))
__device__ __forceinline__ int crow(int r, int hi) { return (r & 3) + 8 * (r >> 2) + 4 * hi; }
__device__ __forceinline__ int v_st(int k, int c) { const int kk = (k & ~0xC) | ((k & 4) << 1) | ((k & 8) >> 1); return ((kk >> 3) * 4 + (c >> 5)) * 512 + ((kk & 7) * 32 + (c & 31)) * 2; }
__device__ __forceinline__ int v_rd_base(int lane) { return ((lane & 3) << 3) | (((lane >> 2) & 3) << 6) | (((lane >> 4) & 1) << 5) | (((lane >> 5) & 1) << 8); }
constexpr int v_rd_off(int d0, int ks, int half) { return d0 * 512 + ks * 4096 + half * 2048; }
template <int OFF> __device__ __forceinline__ s16x4 tr_read(int vb) {
    s16x4 r; asm volatile("ds_read_b64_tr_b16 %0, %1 offset:%2" : "=&v"(r) : "v"(vb), "i"(OFF) : "memory"); return r;
}
template <int D0> __device__ __forceinline__ void pv_one(f32x16& od, int vb, bf16x8 pa0, bf16x8 pa1, bf16x8 pa2, bf16x8 pa3) {
    const s16x4 l0 = tr_read<v_rd_off(D0, 0, 0)>(vb), h0 = tr_read<v_rd_off(D0, 0, 1)>(vb), l1 = tr_read<v_rd_off(D0, 1, 0)>(vb), h1 = tr_read<v_rd_off(D0, 1, 1)>(vb);
    const s16x4 l2 = tr_read<v_rd_off(D0, 2, 0)>(vb), h2 = tr_read<v_rd_off(D0, 2, 1)>(vb), l3 = tr_read<v_rd_off(D0, 3, 0)>(vb), h3 = tr_read<v_rd_off(D0, 3, 1)>(vb);
    asm volatile("s_waitcnt lgkmcnt(0)" ::: "memory"); SBAR();
#define PK(L, H) (bf16x8){L[0], L[1], L[2], L[3], H[0], H[1], H[2], H[3]}
    __builtin_amdgcn_s_setprio(1);
    od = __builtin_amdgcn_mfma_f32_32x32x16_bf16(pa0, PK(l0, h0), od, 0, 0, 0);
    od = __builtin_amdgcn_mfma_f32_32x32x16_bf16(pa1, PK(l1, h1), od, 0, 0, 0);
    od = __builtin_amdgcn_mfma_f32_32x32x16_bf16(pa2, PK(l2, h2), od, 0, 0, 0);
    od = __builtin_amdgcn_mfma_f32_32x32x16_bf16(pa3, PK(l3, h3), od, 0, 0, 0);
    __builtin_amdgcn_s_setprio(0);
#undef PK
}
__device__ __forceinline__ void pv_d0(f32x16* o, int vb, bf16x8 pa0, bf16x8 pa1, bf16x8 pa2, bf16x8 pa3) {
    pv_one<0>(o[0], vb, pa0, pa1, pa2, pa3); pv_one<1>(o[1], vb, pa0, pa1, pa2, pa3); pv_one<2>(o[2], vb, pa0, pa1, pa2, pa3); pv_one<3>(o[3], vb, pa0, pa1, pa2, pa3);
}
__device__ __forceinline__ float max3f(float a, float b, float c) { float r; asm("v_max3_f32 %0, %1, %2, %3" : "=v"(r) : "v"(a), "v"(b), "v"(c)); return r; }
__device__ __forceinline__ void partialSM(f32x16& p0, f32x16& p1, float& m_reg, float& mn, float& alpha, float dq, float nsl2, int side) {
    asm volatile("" : "+v"(dq));
    float A;
    if (side == 0) {
        A = 0.f;
#pragma unroll
        for (int r = 0; r < 16; ++r) { const float c = (float)((r & 3) + 8 * (r >> 2)); p0[r] = fmaf(nsl2, fabsf(dq - c), p0[r]); p1[r] = fmaf(nsl2, fabsf(dq - (c + 32.f)), p1[r]); }
    } else {
        const float coef = side < 0 ? -nsl2 : nsl2;
        A = side < 0 ? nsl2 * dq : -nsl2 * dq;
#pragma unroll
        for (int r = 0; r < 16; ++r) { const float c = (float)((r & 3) + 8 * (r >> 2)); p0[r] = fmaf(coef, c, p0[r]); p1[r] = fmaf(coef, c + 32.f, p1[r]); }
    }
    float pa = max3f(p0[0], p0[1], p1[0]), pb = max3f(p0[2], p0[3], p1[1]); pa = max3f(pa, p1[2], p1[3]);
#pragma unroll
    for (int r = 4; r < 16; r += 4) { pa = max3f(pa, p0[r], p0[r + 1]); pb = max3f(pb, p0[r + 2], p0[r + 3]); pa = max3f(pa, p1[r], p1[r + 1]); pb = max3f(pb, p1[r + 2], p1[r + 3]); }
    float pmax = fmaxf(pa, pb) + A;
    { auto rr = __builtin_amdgcn_permlane32_swap(__float_as_uint(pmax), __float_as_uint(pmax), false, false);
      pmax = fmaxf(__uint_as_float(rr[0]), __uint_as_float(rr[1])); }
    if (__builtin_expect(__all(pmax - m_reg <= THR2), 1)) { mn = m_reg; alpha = 1.f; }
    else { mn = fmaxf(m_reg, pmax); alpha = __builtin_amdgcn_exp2f(m_reg - mn); m_reg = mn; }
    const float sub = mn - A;
#pragma unroll
    for (int r = 0; r < 16; ++r) { p0[r] -= sub; p1[r] -= sub; }
#pragma unroll
    for (int r = 0; r < 16; ++r) p0[r] = __builtin_amdgcn_exp2f(p0[r]);
}
__device__ __forceinline__ void finishSM(f32x16& p0, f32x16& p1, float alpha, float& l_reg, bf16x8& pa0, bf16x8& pa1, bf16x8& pa2, bf16x8& pa3) {
#pragma unroll
    for (int r = 0; r < 16; ++r) p1[r] = __builtin_amdgcn_exp2f(p1[r]);
    float ps = 0;
#pragma unroll
    for (int r = 0; r < 16; ++r) ps += p0[r];
#pragma unroll
    for (int r = 0; r < 16; ++r) ps += p1[r];
    { auto rr = __builtin_amdgcn_permlane32_swap(__float_as_uint(ps), __float_as_uint(ps), false, false);
      ps = __uint_as_float(rr[0]) + __uint_as_float(rr[1]); }
    l_reg = l_reg * alpha + ps;
#define PK4(P, BASE, OUT) do { unsigned a0 = cvt_pk_bf16(P[BASE + 0], P[BASE + 1]), a1 = cvt_pk_bf16(P[BASE + 2], P[BASE + 3]);   \
    unsigned b0 = cvt_pk_bf16(P[BASE + 4], P[BASE + 5]), b1 = cvt_pk_bf16(P[BASE + 6], P[BASE + 7]);                              \
    auto r0 = __builtin_amdgcn_permlane32_swap(a0, b0, false, false); auto r1 = __builtin_amdgcn_permlane32_swap(a1, b1, false, false); \
    u32x4 w = {r0[0], r1[0], r0[1], r1[1]}; OUT = *reinterpret_cast<bf16x8*>(&w); } while (0)
    PK4(p0, 0, pa0); PK4(p0, 8, pa1); PK4(p1, 0, pa2); PK4(p1, 8, pa3);
#undef PK4
}
__device__ __forceinline__ unsigned bf16_bits(float x) { return cvt_pk_bf16(x, 0.f) & 0xffffu; }
__device__ __forceinline__ unsigned pack2(float lo, float hi) { return cvt_pk_bf16(lo, hi); }
__device__ __forceinline__ void qkt_f(f32x16& p0, f32x16& p1, const char* Ks, const char* Qs, int r32, int hi, const f32x16& negm, bool feat, bf16x8 qfeat, bf16x8 kfeat0, bf16x8 kfeat1) {
    bf16x8 qr[4];
#pragma unroll
    for (int d0 = 0; d0 < 4; ++d0) qr[d0] = *reinterpret_cast<const bf16x8*>(Qs + d0 * 1024);
#pragma unroll
    for (int d0 = 0; d0 < 4; ++d0) { const int cb = (d0 * 16 + hi * 8) * 2;
        const bf16x8 b0 = *reinterpret_cast<const bf16x8*>(Ks + KSWZ64(r32, cb));
        const bf16x8 b1 = *reinterpret_cast<const bf16x8*>(Ks + KSWZ64(32 + r32, cb));
        if (d0 == 0) { p0 = __builtin_amdgcn_mfma_f32_32x32x16_bf16(b0, qr[0], negm, 0, 0, 0); p1 = __builtin_amdgcn_mfma_f32_32x32x16_bf16(b1, qr[0], negm, 0, 0, 0); }
        else { p0 = __builtin_amdgcn_mfma_f32_32x32x16_bf16(b0, qr[d0], p0, 0, 0, 0); p1 = __builtin_amdgcn_mfma_f32_32x32x16_bf16(b1, qr[d0], p1, 0, 0, 0); } }
    if (feat) { p0 = __builtin_amdgcn_mfma_f32_32x32x16_bf16(kfeat0, qfeat, p0, 0, 0, 0); p1 = __builtin_amdgcn_mfma_f32_32x32x16_bf16(kfeat1, qfeat, p1, 0, 0, 0); }
}
__device__ __forceinline__ void partialSM_f(f32x16& p0, f32x16& p1, float& m_reg, float& alpha, f32x16& negm, bool diag, float dq, float nsl2) {
    if (diag) {
        asm volatile("" : "+v"(dq));
#pragma unroll
        for (int r = 0; r < 16; ++r) { const float c = (float)((r & 3) + 8 * (r >> 2)); p0[r] = fmaf(nsl2, fabsf(dq - c), p0[r]); p1[r] = fmaf(nsl2, fabsf(dq - (c + 32.f)), p1[r]); }
    }
    float pa = max3f(p0[0], p0[1], p1[0]), pb = max3f(p0[2], p0[3], p1[1]); pa = max3f(pa, p1[2], p1[3]);
#pragma unroll
    for (int r = 4; r < 16; r += 4) { pa = max3f(pa, p0[r], p0[r + 1]); pb = max3f(pb, p0[r + 2], p0[r + 3]); pa = max3f(pa, p1[r], p1[r + 1]); pb = max3f(pb, p1[r + 2], p1[r + 3]); }
    float pmax = fmaxf(pa, pb);
    { auto rr = __builtin_amdgcn_permlane32_swap(__float_as_uint(pmax), __float_as_uint(pmax), false, false);
      pmax = fmaxf(__uint_as_float(rr[0]), __uint_as_float(rr[1])); }
    alpha = 1.f;
    if (__builtin_expect(__any(pmax > THR2), 0)) {
        const float dl = pmax > THR2 ? pmax : 0.f;
        m_reg += dl; alpha = __builtin_amdgcn_exp2f(-dl);
#pragma unroll
        for (int r = 0; r < 16; ++r) { p0[r] -= dl; p1[r] -= dl; negm[r] = -m_reg; }
    }
#pragma unroll
    for (int r = 0; r < 16; ++r) p0[r] = __builtin_amdgcn_exp2f(p0[r]);
}
__device__ __forceinline__ void qkt(f32x16& p0, f32x16& p1, const char* Ks, const char* Qs, int r32, int hi) {
    p0 = f32x16{}; p1 = f32x16{};
    bf16x8 qr[4];
#pragma unroll
    for (int d0 = 0; d0 < 4; ++d0) qr[d0] = *reinterpret_cast<const bf16x8*>(Qs + d0 * 1024);
#pragma unroll
    for (int d0 = 0; d0 < 4; ++d0) { const int cb = (d0 * 16 + hi * 8) * 2;
        const bf16x8 b0 = *reinterpret_cast<const bf16x8*>(Ks + KSWZ64(r32, cb));
        const bf16x8 b1 = *reinterpret_cast<const bf16x8*>(Ks + KSWZ64(32 + r32, cb));
        p0 = __builtin_amdgcn_mfma_f32_32x32x16_bf16(b0, qr[d0], p0, 0, 0, 0);
        p1 = __builtin_amdgcn_mfma_f32_32x32x16_bf16(b1, qr[d0], p1, 0, 0, 0); }
}
#define TIDL() ({ int t_ = threadIdx.x; asm volatile("" : "+v"(t_)); t_; })
__device__ __forceinline__ float sumsq8(u32x4 w) { float s = bflo(w.x) * bflo(w.x); s = fmaf(bfhi(w.x), bfhi(w.x), s); s = fmaf(bflo(w.y), bflo(w.y), s); s = fmaf(bfhi(w.y), bfhi(w.y), s);
    s = fmaf(bflo(w.z), bflo(w.z), s); s = fmaf(bfhi(w.z), bfhi(w.z), s); s = fmaf(bflo(w.w), bflo(w.w), s); s = fmaf(bfhi(w.w), bfhi(w.w), s); return s; }
constexpr float SKIP_T2 = 44.f;
__device__ __forceinline__ void attn_pass(const bf16_t* __restrict__ Qw, const bf16_t* __restrict__ Kh, const bf16_t* __restrict__ Vh, const float* __restrict__ kn2g, char* lds, float qpos_f, float nsl2, int qb,
                                          f32x16 (&o)[4], float& l_out) {
    const int tid = tid_l(), wid = tid >> 6, lane = tid & 63, r32 = lane & 31, hi = lane >> 5;
    char* V_lds = lds + OFF_V; char* K_lds = lds + OFF_K;
    float m_reg = -1e30f, l_reg = 0.f;
#pragma unroll
    for (int d = 0; d < 4; ++d) o[d] = f32x16{};
    char* Qs = lds + OFF_OST + wid * 8192 + lane * 16;
    float* kn2 = (float*)(lds + OFF_NRM); float* qn2 = kn2 + 64;
    {
        float qs = 0.f, sd = 0.f;
        const bf16_t* Kd = Kh + (long)(qb * 256 + wid * QBLK + r32) * 512 + hi * 8;
#pragma unroll
        for (int d0 = 0; d0 < 4; ++d0) { const u32x4 w = *reinterpret_cast<const u32x4*>(Qw + d0 * 16); *reinterpret_cast<u32x4*>(Qs + d0 * 1024) = w; qs += sumsq8(w);
            const u32x4 kk = *reinterpret_cast<const u32x4*>(Kd + d0 * 16);
            sd += bflo(w.x) * bflo(kk.x) + bfhi(w.x) * bfhi(kk.x) + bflo(w.y) * bflo(kk.y) + bfhi(w.y) * bfhi(kk.y) + bflo(w.z) * bflo(kk.z) + bfhi(w.z) * bfhi(kk.z) + bflo(w.w) * bflo(kk.w) + bfhi(w.w) * bfhi(kk.w); }
        { auto rr = __builtin_amdgcn_permlane32_swap(__float_as_uint(qs), __float_as_uint(qs), false, false); qs = __uint_as_float(rr[0]) + __uint_as_float(rr[1]); }
        { auto rr = __builtin_amdgcn_permlane32_swap(__float_as_uint(sd), __float_as_uint(sd), false, false); sd = __uint_as_float(rr[0]) + __uint_as_float(rr[1]); }
        const float wm = wave_max(qs), wd = -wave_max(-sd);
        if (lane == 0) { qn2[wid] = wm; qn2[8 + wid] = wd; }
        float km = 0.f;
#pragma unroll
        for (int i = 0; i < 8; ++i) km = fmaxf(km, kn2g[(long)(tid * 8 + i) * 8]);
        km = fmaxf(km, swz_xor<1>(km)); km = fmaxf(km, swz_xor<2>(km)); km = fmaxf(km, swz_xor<4>(km));
        if ((tid & 7) == 0) kn2[tid >> 3] = km;
    }
    __syncthreads();
    int t_lo, t_hi;
    {
        float Qn2 = qn2[0], smin = qn2[8];
#pragma unroll
        for (int i = 1; i < 8; ++i) { Qn2 = fmaxf(Qn2, qn2[i]); smin = fminf(smin, qn2[8 + i]); }
        smin -= 0.05f + 1e-3f * fabsf(smin);
        const float Qn = sqrtf(Qn2) * 1.01f, Kt = sqrtf(kn2[lane]) * 1.01f;
        const int q0b = qb * 256, kt0 = lane * 64;
        const int dmin = (kt0 + 63 < q0b) ? (q0b - (kt0 + 63)) : ((kt0 > q0b + 255) ? (kt0 - (q0b + 255)) : 0);
        const bool need = !(Qn * Kt - smin + nsl2 * (float)dmin <= -SKIP_T2);
        const unsigned long long mask = __ballot(need);
        t_lo = (int)__builtin_ctzll(mask); t_hi = 63 - (int)__builtin_clzll(mask);
        if (((t_hi - t_lo) & 1) == 0) { if (t_hi < 63) ++t_hi; else --t_lo; }
        t_lo = __builtin_amdgcn_readfirstlane(t_lo); t_hi = __builtin_amdgcn_readfirstlane(t_hi);
    }
    const int NTe = t_hi - t_lo + 1;
    Kh += (long)t_lo * KVBLK * 512; Vh += (long)t_lo * KVBLK * 512;
    unsigned kofs, vofs0, vofs1;
    { const int p = wid * 64 + lane, krow = p >> 3, kch = (p & 7) ^ ((krow >> 1) & 7); kofs = (unsigned)(krow * 512 + kch * 8) * 2u;
      const int l5 = lane & 31, kklo = l5 >> 2, cin = (lane & 3) * 8;
#pragma unroll
      for (int q = 0; q < 2; ++q) { const int sub = 2 * (2 * wid + q) + (lane >> 5), kkhi = sub >> 2, cblk = sub & 3, kk = kkhi * 8 + kklo, k = (kk & ~0xC) | ((kk & 4) << 1) | ((kk & 8) >> 1), c = cblk * 32 + cin;
          const unsigned v = (unsigned)(k * 512 + c) * 2u; if (q == 0) vofs0 = v; else vofs1 = v; } }
    const unsigned ldsK = (unsigned)__builtin_amdgcn_readfirstlane(wid * 1024), ldsV = (unsigned)__builtin_amdgcn_readfirstlane(wid * 2048);
    LAS unsigned char* lds3 = (LAS unsigned char*)(uintptr_t)(unsigned)(uintptr_t)lds;
#define DMA_K(t, slot) do { const int tt_ = (t) < NTe ? (t) : NTe - 1; __builtin_amdgcn_global_load_lds((const unsigned*)((const char*)Kh + (size_t)tt_ * (KVBLK * 512 * 2) + kofs), (LAS unsigned*)(lds3 + OFF_K + (slot) * SHM_K + ldsK), 16, 0, 0); } while (0)
#define DMA_V(t, slot) do { const int tt_ = (t) < NTe ? (t) : NTe - 1; const char* vb_ = (const char*)Vh + (size_t)tt_ * (KVBLK * 512 * 2); \
    __builtin_amdgcn_global_load_lds((const unsigned*)(vb_ + vofs0), (LAS unsigned*)(lds3 + OFF_V + (slot) * SHM_V + ldsV), 16, 0, 0); \
    __builtin_amdgcn_global_load_lds((const unsigned*)(vb_ + vofs1), (LAS unsigned*)(lds3 + OFF_V + (slot) * SHM_V + ldsV + 1024), 16, 0, 0); } while (0)
#define WAITBAR(n) do { asm volatile("s_waitcnt vmcnt(" #n ")" ::: "memory"); __builtin_amdgcn_s_barrier(); asm volatile("" ::: "memory"); } while (0)
#define VB(slot) ((int)(uintptr_t)V_lds + (slot) * SHM_V + v_rd_base(TIDL() & 63))
#define RESC(a) do { if (__any((a) < 1.f)) { const int t_ = TIDL(); float* al_l = (float*)(lds + OFF_WS) + (t_ >> 6) * 64 + 32; if (((t_ >> 5) & 1) == 0) al_l[t_ & 31] = (a); asm volatile("s_waitcnt lgkmcnt(0)" ::: "memory"); \
    _Pragma("unroll") for (int d = 0; d < 4; ++d) _Pragma("unroll") for (int r = 0; r < 16; ++r) o[d][r] *= al_l[crow(r, (t_ >> 5) & 1)]; } } while (0)
    m_reg = 0.f;
    f32x16 negm = f32x16{};
    bf16x8 qfeat, kfl0, kfl1; unsigned kf01, kf23, kfb0, kfb1;
    { const float sl2 = -nsl2; const float s_hi = bf2f((unsigned short)bf16_bits(sl2)), s_lo = bf2f((unsigned short)bf16_bits(sl2 - s_hi));
      const int qpos_i = (int)qpos_f; const float a_q = (float)(qpos_i >> 6), b_q = (float)(qpos_i & 63);
      const unsigned z = hi == 0 ? 0xffffffffu : 0u;
      u32x4 qf; qf.x = pack2(a_q, a_q) & z; qf.y = pack2(b_q, b_q) & z; qf.z = pack2(64.f * s_hi, 64.f * s_lo) & z; qf.w = pack2(s_hi, s_lo) & z; qfeat = __builtin_bit_cast(bf16x8, qf);
      kf01 = pack2(-64.f * s_hi, -64.f * s_lo) & z; kf23 = pack2(-s_hi, -s_lo) & z; kfb0 = pack2((float)r32, (float)r32) & z; kfb1 = pack2((float)(r32 + 32), (float)(r32 + 32)) & z; }
#define KFEAT(j) do { const int sd_ = SIDE(j); const float ak_ = (float)(t_lo + (j)); const unsigned sg_ = sd_ > 0 ? 0x80008000u : 0u, ka_ = (hi == 0 ? pack2(ak_, ak_) : 0u) ^ sg_; \
    u32x4 k0_ = {kf01 ^ sg_, kf23 ^ sg_, ka_, kfb0 ^ sg_}, k1_ = {kf01 ^ sg_, kf23 ^ sg_, ka_, kfb1 ^ sg_}; kfl0 = __builtin_bit_cast(bf16x8, k0_); kfl1 = __builtin_bit_cast(bf16x8, k1_); } while (0)
    const float dq0 = qpos_f - 4.f * hi - 64.f * (float)t_lo;
    const int tdw = __builtin_amdgcn_readfirstlane((qb * 256 + wid * QBLK) >> 6) - t_lo;
#define SIDE(j) ((j) < tdw ? -1 : ((j) > tdw ? 1 : 0))
    int s0 = 0, s1 = 1, s2 = 2;
#define ROT() do { const int t_ = s0; s0 = s1; s1 = s2; s2 = t_; } while (0)
    int kad[4];
#pragma unroll
    for (int d0 = 0; d0 < 4; ++d0) kad[d0] = (int)(uintptr_t)K_lds + KSWZ64(r32, (d0 * 16 + hi * 8) * 2);
    const int qad = (int)(uintptr_t)Qs;
    const int vad = (int)(uintptr_t)V_lds + v_rd_base(lane);
    bf16x8 fq0, fa0, fb0, fq1, fa1, fb1;
    s16x4 tv[8];
    f32x16 pA0, pA1, pB0, pB1; float alA = 1.f, alB = 1.f; bf16x8 pa0, pa1, pa2, pa3;
#define LR128(dst, addr, OFF) asm volatile("ds_read_b128 %0, %1 offset:%2" : "=&v"(dst) : "v"(addr), "i"(OFF) : "memory")
#define LRTR(dst, addr, OFF) asm volatile("ds_read_b64_tr_b16 %0, %1 offset:%2" : "=&v"(dst) : "v"(addr), "i"(OFF) : "memory")
#define LWAIT(n) do { asm volatile("s_waitcnt lgkmcnt(" #n ")" ::: "memory"); SBAR(); } while (0)
#define RDF0(d0, kso) do { LR128(fq0, qad, (d0) * 1024); const int ka_ = kad[d0] + (kso); LR128(fa0, ka_, 0); LR128(fb0, ka_, 4096); } while (0)
#define RDF1(d0, kso) do { LR128(fq1, qad, (d0) * 1024); const int ka_ = kad[d0] + (kso); LR128(fa1, ka_, 0); LR128(fb1, ka_, 4096); } while (0)
#define VRD(D0, va_) do { LRTR(tv[0], va_, v_rd_off(D0, 0, 0)); LRTR(tv[1], va_, v_rd_off(D0, 0, 1)); LRTR(tv[2], va_, v_rd_off(D0, 1, 0)); LRTR(tv[3], va_, v_rd_off(D0, 1, 1)); \
    LRTR(tv[4], va_, v_rd_off(D0, 2, 0)); LRTR(tv[5], va_, v_rd_off(D0, 2, 1)); LRTR(tv[6], va_, v_rd_off(D0, 3, 0)); LRTR(tv[7], va_, v_rd_off(D0, 3, 1)); } while (0)
#define TVK(k) (bf16x8){tv[2 * (k)][0], tv[2 * (k)][1], tv[2 * (k)][2], tv[2 * (k)][3], tv[2 * (k) + 1][0], tv[2 * (k) + 1][1], tv[2 * (k) + 1][2], tv[2 * (k) + 1][3]}
#define MF(acc, a, b, c) acc = __builtin_amdgcn_mfma_f32_32x32x16_bf16(a, b, c, 0, 0, 0)
#define PIN(x) asm volatile("" : "+v"(x))
#define SUM4(Y, B) do { sacc += Y[B]; sacc += Y[B + 1]; sacc += Y[B + 2]; sacc += Y[B + 3]; PIN(sacc); } while (0)
#define PKLO(Y, B) do { ca_ = cvt_pk_bf16(Y[B], Y[B + 1]); cb_ = cvt_pk_bf16(Y[B + 2], Y[B + 3]); } while (0)
#define PKHI(Y, B, OUT) do { const unsigned c0_ = cvt_pk_bf16(Y[B], Y[B + 1]), c1_ = cvt_pk_bf16(Y[B + 2], Y[B + 3]); \
    auto r0_ = __builtin_amdgcn_permlane32_swap(ca_, c0_, false, false); auto r1_ = __builtin_amdgcn_permlane32_swap(cb_, c1_, false, false); \
    u32x4 w_ = {r0_[0], r1_[0], r0_[1], r1_[1]}; OUT = __builtin_bit_cast(bf16x8, w_); PIN(OUT); } while (0)
#define CV4(Y, B, i) do { pk_[i] = cvt_pk_bf16(Y[B], Y[B + 1]); pk_[i + 1] = cvt_pk_bf16(Y[B + 2], Y[B + 3]); PIN(pk_[i]); PIN(pk_[i + 1]); } while (0)
#define SWP(i, OUT) do { auto r0_ = __builtin_amdgcn_permlane32_swap(pk_[i], pk_[i + 2], false, false); auto r1_ = __builtin_amdgcn_permlane32_swap(pk_[i + 1], pk_[i + 3], false, false); \
    u32x4 w_ = {r0_[0], r1_[0], r0_[1], r1_[1]}; OUT = __builtin_bit_cast(bf16x8, w_); PIN(OUT); } while (0)
#define VRDA(D0, va_) do { LRTR(tv[0], va_, v_rd_off(D0, 0, 0)); LRTR(tv[1], va_, v_rd_off(D0, 0, 1)); LRTR(tv[2], va_, v_rd_off(D0, 1, 0)); LRTR(tv[3], va_, v_rd_off(D0, 1, 1)); } while (0)
#define VRDB(D0, va_) do { LRTR(tv[4], va_, v_rd_off(D0, 2, 0)); LRTR(tv[5], va_, v_rd_off(D0, 2, 1)); LRTR(tv[6], va_, v_rd_off(D0, 3, 0)); LRTR(tv[7], va_, v_rd_off(D0, 3, 1)); } while (0)
#define MX3(m, a, b) do { m = __builtin_fmaxf(__builtin_fmaxf(m, a), b); } while (0)
#define EX3(X, a, b, c) do { float ea_ = EX(X[a]), eb_ = EX(X[b]), ec_ = EX(X[c]); asm volatile("" : "+v"(ea_), "+v"(eb_), "+v"(ec_)); X[a] = ea_; X[b] = eb_; X[c] = ec_; } while (0)
#define STEP(X0, X1, Y0, Y1, alY, alX, J, HAVE_PREV, DMAS) do { \
    const int kso_ = s1_cur * SHM_K, vso_ = vad + s0_cur * SHM_V; const int sd_ = SIDE(J); const bool feat_ = sd_ != 0; \
    float sacc = 0.f; unsigned pk_[16]; \
    WAITBAR(3); \
    RDF0(0, kso_); RDF1(1, kso_); \
    DMAS; \
    KFEAT(J); \
    LWAIT(3); \
    MF(X0, fa0, fq0, negm); if (HAVE_PREV) { SUM4(Y0, 0); CV4(Y0, 0, 0); } SBAR(); \
    MF(X1, fb0, fq0, negm); if (HAVE_PREV) { SUM4(Y0, 4); CV4(Y0, 4, 2); } SBAR(); \
    RDF0(2, kso_); LWAIT(3); \
    MF(X0, fa1, fq1, X0); if (HAVE_PREV) { SUM4(Y0, 8); CV4(Y0, 8, 4); } SBAR(); \
    MF(X1, fb1, fq1, X1); if (HAVE_PREV) { SUM4(Y0, 12); CV4(Y0, 12, 6); } SBAR(); \
    RDF1(3, kso_); LWAIT(3); \
    MF(X0, fa0, fq0, X0); if (HAVE_PREV) { SUM4(Y1, 0); CV4(Y1, 0, 8); } SBAR(); \
    MF(X1, fb0, fq0, X1); if (HAVE_PREV) { SUM4(Y1, 4); CV4(Y1, 4, 10); } SBAR(); \
    LWAIT(0); \
    MF(X0, fa1, fq1, X0); if (HAVE_PREV) { SUM4(Y1, 8); CV4(Y1, 8, 12); } SBAR(); \
    MF(X1, fb1, fq1, X1); if (HAVE_PREV) { SUM4(Y1, 12); CV4(Y1, 12, 14); } SBAR(); \
    if (HAVE_PREV) VRD(0, vso_); \
    if (feat_) { MF(X0, kfl0, qfeat, X0); } \
    if (HAVE_PREV) { SWP(0, pa0); SWP(4, pa1); } SBAR(); \
    if (feat_) { MF(X1, kfl1, qfeat, X1); } \
    if (HAVE_PREV) { SWP(8, pa2); SWP(12, pa3); \
        auto rr_ = __builtin_amdgcn_permlane32_swap(__float_as_uint(sacc), __float_as_uint(sacc), false, false); l_reg = l_reg * (alY) + (__uint_as_float(rr_[0]) + __uint_as_float(rr_[1])); PIN(l_reg); } \
    SBAR(); \
    if (!feat_) { float dq_ = dq0 - 64.f * (float)(J); asm volatile("" : "+v"(dq_)); \
        _Pragma("unroll") for (int r = 0; r < 16; ++r) { const float c = (float)((r & 3) + 8 * (r >> 2)); X0[r] = fmaf(nsl2, fabsf(dq_ - c), X0[r]); X1[r] = fmaf(nsl2, fabsf(dq_ - (c + 32.f)), X1[r]); } } \
    SBAR(); \
    float ma_, mb_; \
    if (HAVE_PREV) { LWAIT(0); MF(o[0], pa0, TVK(0), o[0]); } \
    ma_ = __builtin_fmaxf(__builtin_fmaxf(X0[0], X0[1]), X0[2]); MX3(ma_, X0[3], X0[4]); mb_ = __builtin_fmaxf(__builtin_fmaxf(X0[5], X0[6]), X0[7]); MX3(mb_, X0[8], X0[9]); PIN(ma_); PIN(mb_); SBAR(); \
    if (HAVE_PREV) { MF(o[0], pa1, TVK(1), o[0]); } \
    MX3(ma_, X0[10], X0[11]); MX3(mb_, X0[12], X0[13]); MX3(ma_, X0[14], X0[15]); MX3(mb_, X1[0], X1[1]); PIN(ma_); PIN(mb_); SBAR(); \
    if (HAVE_PREV) { VRDA(1, vso_); MF(o[0], pa2, TVK(2), o[0]); } \
    MX3(ma_, X1[2], X1[3]); MX3(mb_, X1[4], X1[5]); MX3(ma_, X1[6], X1[7]); MX3(mb_, X1[8], X1[9]); PIN(ma_); PIN(mb_); SBAR(); \
    if (HAVE_PREV) { MF(o[0], pa3, TVK(3), o[0]); } \
    MX3(ma_, X1[10], X1[11]); MX3(mb_, X1[12], X1[13]); MX3(ma_, X1[14], X1[15]); \
    { float pm_ = __builtin_fmaxf(ma_, mb_); { auto rr_ = __builtin_amdgcn_permlane32_swap(__float_as_uint(pm_), __float_as_uint(pm_), false, false); pm_ = __builtin_fmaxf(__uint_as_float(rr_[0]), __uint_as_float(rr_[1])); } \
      SBAR(); \
      if (HAVE_PREV) { VRDB(1, vso_); } \
      alX = 1.f; \
      if (__builtin_expect(__any(pm_ > THR2), 0)) { const float dl_ = pm_ > THR2 ? pm_ : 0.f; m_reg += dl_; alX = __builtin_amdgcn_exp2f(-dl_); \
          _Pragma("unroll") for (int r = 0; r < 16; ++r) { X0[r] -= dl_; X1[r] -= dl_; negm[r] = -m_reg; } } } \
    SBAR(); \
    if (HAVE_PREV) { \
      LWAIT(4); MF(o[1], pa0, TVK(0), o[1]); EX3(X0, 0, 1, 2); SBAR(); MF(o[1], pa1, TVK(1), o[1]); EX3(X0, 3, 4, 5); SBAR(); VRDA(2, vso_); \
      LWAIT(4); MF(o[1], pa2, TVK(2), o[1]); EX3(X0, 6, 7, 8); SBAR(); MF(o[1], pa3, TVK(3), o[1]); EX3(X0, 9, 10, 11); SBAR(); VRDB(2, vso_); \
      LWAIT(4); MF(o[2], pa0, TVK(0), o[2]); EX3(X0, 12, 13, 14); SBAR(); MF(o[2], pa1, TVK(1), o[2]); EX3(X1, 0, 1, 2); SBAR(); VRDA(3, vso_); \
      LWAIT(4); MF(o[2], pa2, TVK(2), o[2]); EX3(X1, 3, 4, 5); SBAR(); MF(o[2], pa3, TVK(3), o[2]); EX3(X1, 6, 7, 8); SBAR(); VRDB(3, vso_); \
      LWAIT(4); MF(o[3], pa0, TVK(0), o[3]); EX2(X1, 9, 10); SBAR(); MF(o[3], pa1, TVK(1), o[3]); EX2(X1, 11, 12); SBAR(); \
      LWAIT(0); MF(o[3], pa2, TVK(2), o[3]); EX2(X1, 13, 14); SBAR(); MF(o[3], pa3, TVK(3), o[3]); { float ea_ = EX(X0[15]), eb_ = EX(X1[15]); asm volatile("" : "+v"(ea_), "+v"(eb_)); X0[15] = ea_; X1[15] = eb_; } SBAR(); \
    } else { _Pragma("unroll") for (int r = 0; r < 16; ++r) { X0[r] = EX(X0[r]); X1[r] = EX(X1[r]); } } \
  } while (0)
#define EX(v) __builtin_amdgcn_exp2f(v)
#define EX2(X, a, b) do { float ea_ = EX(X[a]), eb_ = EX(X[b]); asm volatile("" : "+v"(ea_), "+v"(eb_)); X[a] = ea_; X[b] = eb_; } while (0)
    int s0_cur, s1_cur;
    asm volatile("s_waitcnt vmcnt(0) lgkmcnt(0)" ::: "memory"); __builtin_amdgcn_s_barrier();
    DMA_K(0, 0); DMA_V(0, 0); DMA_K(1, 1);
    s1_cur = s0; s0_cur = s0;
    STEP(pA0, pA1, pB0, pB1, alB, alA, 0, false, { DMA_K(2, s2); DMA_V(1, s1); });
    for (int j = 1; j + 1 < NTe; j += 2) {
        s1_cur = s1; s0_cur = s0;
        STEP(pB0, pB1, pA0, pA1, alA, alB, j, true, { DMA_K(j + 2, s0); DMA_V(j + 1, s2); });
        RESC(alB); ROT();
        s1_cur = s1; s0_cur = s0;
        STEP(pA0, pA1, pB0, pB1, alB, alA, j + 1, true, { DMA_K(j + 3, s0); DMA_V(j + 2, s2); });
        RESC(alA); ROT();
    }
    s1_cur = s1; s0_cur = s0;
    STEP(pB0, pB1, pA0, pA1, alA, alB, NTe - 1, true, { DMA_K(NTe, s0); DMA_V(NTe, s2); });
    RESC(alB); ROT();
    WAITBAR(0);
    { float sacc = 0.f; unsigned pk_[16];
      SUM4(pB0, 0); CV4(pB0, 0, 0); SUM4(pB0, 4); CV4(pB0, 4, 2); SUM4(pB0, 8); CV4(pB0, 8, 4); SUM4(pB0, 12); CV4(pB0, 12, 6);
      SUM4(pB1, 0); CV4(pB1, 0, 8); SUM4(pB1, 4); CV4(pB1, 4, 10); SUM4(pB1, 8); CV4(pB1, 8, 12); SUM4(pB1, 12); CV4(pB1, 12, 14);
      SWP(0, pa0); SWP(4, pa1); SWP(8, pa2); SWP(12, pa3);
      auto rr_ = __builtin_amdgcn_permlane32_swap(__float_as_uint(sacc), __float_as_uint(sacc), false, false); l_reg = l_reg * alB + (__uint_as_float(rr_[0]) + __uint_as_float(rr_[1])); }
    SBAR();
    pv_d0(o, VB(s0), pa0, pa1, pa2, pa3);
#undef LR128
#undef LRTR
#undef LWAIT
#undef RDF0
#undef RDF1
#undef VRD
#undef TVK
#undef MF
#undef PIN
#undef SUM4
#undef PKLO
#undef PKHI
#undef STEP
#undef EX
#undef EX2
#undef EX3
#undef CV4
#undef SWP
#undef VRDA
#undef VRDB
#undef MX3
    l_out = l_reg;
#undef DMA_K
#undef DMA_V
#undef WAITBAR
#undef RESC
#undef VB
#undef ROT
#undef SIDE
#undef KFEAT
}
__device__ __forceinline__ void attn_unit(int b, int h, int qb, const bf16_t* Q, const bf16_t* K, const bf16_t* V, const float* KN2, bf16_t* BR, float* park, const float* subln_g, float lam, char* lds) {
    const long rowbase = (long)b * SEQ;
    const float nsl2 = -exp2f(-2.f * (float)(h + 1)) * LOG2E;
    f32x16 o[4]; float l;
#pragma unroll 1
    for (int c = 0; c < 2; ++c) {
        {
            const int tid = tid_l(), wid = tid >> 6, lane = tid & 63, r32 = lane & 31, hi = lane >> 5;
            const int q0 = qb * 256 + wid * QBLK;
            const bf16_t* Qw = Q + (rowbase + q0 + r32) * 512 + h * 128 + c * 64 + hi * 8;
            const bf16_t* Kh = K + rowbase * 512 + h * 128 + c * 64;
            const bf16_t* Vh = V + rowbase * 512 + h * 128;
            attn_pass(Qw, Kh, Vh, KN2 + rowbase * 8 + h * 2 + c, lds, (float)(q0 + r32), nsl2, qb, o, l);
        }
        int tid = threadIdx.x; asm volatile("" : "+v"(tid));
        const int wid = __builtin_amdgcn_readfirstlane(tid >> 6), lane = tid & 63, r32 = lane & 31, hi = lane >> 5;
        float* ws = (float*)(lds + OFF_WS) + wid * 64;
        if (hi == 0) ws[r32] = l; asm volatile("s_waitcnt lgkmcnt(0)" ::: "memory");
        float rli[16];
#pragma unroll
        for (int r = 0; r < 16; ++r) rli[r] = __builtin_amdgcn_rcpf(ws[crow(r, hi)]);
        float* pkl = park + (size_t)wid * 64 * 64 + lane;
        if (c == 0) {
#pragma unroll
            for (int d0 = 0; d0 < 4; ++d0) { float* pp = pkl + d0 * 16 * 64; asm volatile("" : "+v"(pp));
#pragma unroll
                for (int r = 0; r < 16; ++r) pp[r * 64] = o[d0][r] * rli[r]; }
            asm volatile("s_waitcnt vmcnt(0)" ::: "memory");
        } else {
            float ss[16];
#pragma unroll
            for (int r = 0; r < 16; ++r) ss[r] = 0.f;
#pragma unroll
            for (int d0 = 0; d0 < 4; ++d0) { const float* pp = pkl + d0 * 16 * 64; asm volatile("" : "+v"(pp));
#pragma unroll
                for (int r = 0; r < 16; ++r) { const float dv = pp[r * 64] - lam * (o[d0][r] * rli[r]); o[d0][r] = dv; ss[r] += dv * dv; } }
#pragma unroll
            for (int r = 0; r < 16; ++r) {
                ss[r] = half_sum(ss[r]);
                ss[r] = rsqrtf(ss[r] * (1.f / 128.f) + EPS) * 0.8f; }
            float gsub[4];
#pragma unroll
            for (int d0 = 0; d0 < 4; ++d0) gsub[d0] = subln_g[d0 * 32 + r32];
            const int q0 = qb * 256 + wid * QBLK;
            bf16_t* Ow = BR + (rowbase + q0) * 1024 + h * 128 + (long)(lane >> 4) * 1024 + (lane & 15) * 8;
            bf16_t* stg = (bf16_t*)(lds + OFF_OST) + wid * (32 * 128);
            bf16_t* sw = stg + (4 * hi) * 128 + r32;
#pragma unroll
            for (int r = 0; r < 16; ++r) {
#pragma unroll
                for (int d0 = 0; d0 < 4; ++d0) { const unsigned w = cvt_pk_bf16(o[d0][r] * ss[r] * gsub[d0], 0.f); sw[((r & 3) + 8 * (r >> 2)) * 128 + d0 * 32] = (bf16_t)(w & 0xffffu); } }
            asm volatile("s_waitcnt lgkmcnt(0)" ::: "memory");
#pragma unroll
            for (int i = 0; i < 8; ++i) { const int row = i * 4 + (lane >> 4), ch = lane & 15; const u32x4 v = *(const u32x4*)(stg + row * 128 + ch * 8); *(u32x4*)(Ow + (long)i * 4096) = v; }
        }
        __syncthreads();
    }
}
__device__ __forceinline__ void attn_naive(Frame& F, const bf16_t* Q, const bf16_t* K, const bf16_t* V, bf16_t* BR, const float* subln_g, float lam) {
    const int gw = F.vcu * NWAVES + F.wave, NGW = F.G * NWAVES, lane = F.lane;
    for (int item = gw; item < MTOK * 4; item += NGW) {
        const int row = item >> 2, h = item & 3, b = row >> 12, qpos = row & 4095;
        const float sl2 = exp2f(-2.f * (float)(h + 1)) * LOG2E;
        float res0 = 0.f, res1 = 0.f;
        for (int c = 0; c < 2; ++c) {
            const bf16_t* qp = Q + (size_t)row * 512 + h * 128 + c * 64;
            float m = -1e30f, l = 0.f, o0 = 0.f, o1 = 0.f;
            for (int j0 = 0; j0 < SEQ; j0 += 64) {
                const int j = j0 + lane;
                const bf16_t* kp = K + ((size_t)b * SEQ + j) * 512 + h * 128 + c * 64;
                float s = 0.f;
                for (int d = 0; d < 64; d += 8) { const u32x4 qv = *(const u32x4*)(qp + d), kv = *(const u32x4*)(kp + d);
                    s += bflo(qv.x) * bflo(kv.x) + bfhi(qv.x) * bfhi(kv.x) + bflo(qv.y) * bflo(kv.y) + bfhi(qv.y) * bfhi(kv.y) + bflo(qv.z) * bflo(kv.z) + bfhi(qv.z) * bfhi(kv.z) + bflo(qv.w) * bflo(kv.w) + bfhi(qv.w) * bfhi(kv.w); }
                s -= sl2 * fabsf((float)(qpos - j));
                const float mn = fmaxf(m, wave_max(s)), f = exp2f(m - mn), pj = exp2f(s - mn);
                l = l * f + wave_sum(pj); o0 *= f; o1 *= f; m = mn;
                const bf16_t* vp = V + ((size_t)b * SEQ + j0) * 512 + h * 128 + lane * 2;
                for (int t = 0; t < 64; ++t) { const float pt = __shfl(pj, t); const unsigned vv = *(const unsigned*)(vp + (size_t)t * 512); o0 = fmaf(pt, bflo(vv), o0); o1 = fmaf(pt, bfhi(vv), o1); }
            }
            const float il = 1.f / l;
            if (c == 0) { res0 = o0 * il; res1 = o1 * il; } else { res0 -= lam * o0 * il; res1 -= lam * o1 * il; }
        }
        const float ss = wave_sum(res0 * res0 + res1 * res1);
        const float r = rsqrtf(ss * (1.f / 128.f) + EPS) * 0.8f;
        *(unsigned*)(BR + (size_t)row * 1024 + h * 128 + lane * 2) = cvt_pk_bf16(res0 * r * subln_g[lane * 2], res1 * r * subln_g[lane * 2 + 1]);
    }
}
__device__ __forceinline__ void sgu_item(int item, const bf16_t* U, const bf16_t* Sx, const bf16_t* Wsb, const float* ln_g, const float* ln_b, const float* bs, bf16_t* BR, char* lds) {
    const int tid = tid_l(), wid = tid >> 6, lane = tid & 63, r32 = lane & 31, hi = lane >> 5;
    const long row0 = (long)item * 128;
    float lg[8], lb[8];
#pragma unroll
    for (int j = 0; j < 8; ++j) { lg[j] = ln_g[lane * 8 + j]; lb[j] = ln_b[lane * 8 + j]; }
    const int g_l = lane >> 4, d_l = (lane & 15) * 8;
    {
        u32x4 raw[16]; float sm[16], sq[16];
#pragma unroll
        for (int t = 0; t < 16; ++t) raw[t] = *(const u32x4*)(Sx + (row0 + wid * 16 + t) * 512 + lane * 8);
#pragma unroll
        for (int t = 0; t < 16; ++t) { const u32x4 r_ = raw[t];
            const float v[8] = {bflo(r_.x), bfhi(r_.x), bflo(r_.y), bfhi(r_.y), bflo(r_.z), bfhi(r_.z), bflo(r_.w), bfhi(r_.w)};
            float a = 0.f, q = 0.f;
#pragma unroll
            for (int j = 0; j < 8; ++j) { a += v[j]; q = fmaf(v[j], v[j], q); }
            sm[t] = a; sq[t] = q; }
#pragma unroll
        for (int t = 0; t < 16; ++t) { sm[t] = half_sum(sm[t]); sq[t] = half_sum(sq[t]); }
#pragma unroll
        for (int t = 0; t < 16; ++t) {
            const float s_all = __int_as_float(__builtin_amdgcn_readlane(__float_as_int(sm[t]), 0)) + __int_as_float(__builtin_amdgcn_readlane(__float_as_int(sm[t]), 32));
            const float q_all = __int_as_float(__builtin_amdgcn_readlane(__float_as_int(sq[t]), 0)) + __int_as_float(__builtin_amdgcn_readlane(__float_as_int(sq[t]), 32));
            const float mu = s_all * (1.f / 512.f), var = fmaxf(q_all * (1.f / 512.f) - mu * mu, 0.f), rstd = rsqrtf(var + EPS), nm = -mu * rstd;
            const int s = wid * 16 + t; const u32x4 r_ = raw[t];
            const float v[8] = {bflo(r_.x), bfhi(r_.x), bflo(r_.y), bfhi(r_.y), bflo(r_.z), bfhi(r_.z), bflo(r_.w), bfhi(r_.w)};
            float o[8];
#pragma unroll
            for (int j = 0; j < 8; ++j) o[j] = fmaf(fmaf(v[j], rstd, nm), lg[j], lb[j]);
            u32x4 w; w.x = cvt_pk_bf16(o[0], o[1]); w.y = cvt_pk_bf16(o[2], o[3]); w.z = cvt_pk_bf16(o[4], o[5]); w.w = cvt_pk_bf16(o[6], o[7]);
            *(u32x4*)(lds + g_l * 32768 + (s >> 6) * 16384 + v_st(s & 63, d_l)) = w;
        }
    }
    __syncthreads();
    const int g = wid >> 1;
    const int vb0 = (int)(uintptr_t)lds + g * 32768 + v_rd_base(lane);
    f32x16 oa[4], ob[4];
#pragma unroll
    for (int d = 0; d < 4; ++d) { oa[d] = f32x16{}; ob[d] = f32x16{}; }
    {
        const bf16_t* wrow = Wsb + ((size_t)g * 128 + 64 * (wid & 1) + r32) * 128 + hi * 8;
#pragma unroll
        for (int T = 0; T < 2; ++T) {
            const bf16x8 pa0 = *reinterpret_cast<const bf16x8*>(wrow + T * 64 + 0), pa1 = *reinterpret_cast<const bf16x8*>(wrow + T * 64 + 16);
            const bf16x8 pa2 = *reinterpret_cast<const bf16x8*>(wrow + T * 64 + 32), pa3 = *reinterpret_cast<const bf16x8*>(wrow + T * 64 + 48);
            pv_d0(oa, vb0 + T * 16384, pa0, pa1, pa2, pa3);
        }
        const bf16_t* wrow2 = wrow + 32 * 128;
#pragma unroll
        for (int T = 0; T < 2; ++T) {
            const bf16x8 pa0 = *reinterpret_cast<const bf16x8*>(wrow2 + T * 64 + 0), pa1 = *reinterpret_cast<const bf16x8*>(wrow2 + T * 64 + 16);
            const bf16x8 pa2 = *reinterpret_cast<const bf16x8*>(wrow2 + T * 64 + 32), pa3 = *reinterpret_cast<const bf16x8*>(wrow2 + T * 64 + 48);
            pv_d0(ob, vb0 + T * 16384, pa0, pa1, pa2, pa3);
        }
    }
    __syncthreads();
    bf16_t* stg = (bf16_t*)(lds + wid * 16384);
    {
        const int t0 = 64 * (wid & 1);
        bf16_t* sw = stg + (4 * hi) * 128 + r32;
#pragma unroll
        for (int r = 0; r < 16; ++r) { const int rr = (r & 3) + 8 * (r >> 2); const float ba = bs[g * 128 + t0 + rr + 4 * hi], bb = bs[g * 128 + t0 + 32 + rr + 4 * hi];
#pragma unroll
            for (int d0 = 0; d0 < 4; ++d0) { sw[rr * 128 + d0 * 32] = (bf16_t)(cvt_pk_bf16(oa[d0][r] + ba, 0.f) & 0xffffu); sw[(32 + rr) * 128 + d0 * 32] = (bf16_t)(cvt_pk_bf16(ob[d0][r] + bb, 0.f) & 0xffffu); } }
        asm volatile("s_waitcnt lgkmcnt(0)" ::: "memory");
#pragma unroll
        for (int i = 0; i < 16; ++i) { const int row = i * 4 + (lane >> 4), ch = lane & 15; const long tok = row0 + t0 + row; const int c = g * 128 + ch * 8;
            const u32x4 z = *(const u32x4*)(stg + row * 128 + ch * 8), uu = *(const u32x4*)(U + tok * 512 + c);
            u32x4 w; w.x = cvt_pk_bf16(bflo(uu.x) * bflo(z.x), bfhi(uu.x) * bfhi(z.x)); w.y = cvt_pk_bf16(bflo(uu.y) * bflo(z.y), bfhi(uu.y) * bfhi(z.y));
            w.z = cvt_pk_bf16(bflo(uu.z) * bflo(z.z), bfhi(uu.z) * bfhi(z.z)); w.w = cvt_pk_bf16(bflo(uu.w) * bflo(z.w), bfhi(uu.w) * bfhi(z.w));
            *(u32x4*)(BR + tok * 1024 + 512 + c) = w; }
    }
    __syncthreads();
}
__device__ __forceinline__ void sgu_naive(int item, const bf16_t* U, const bf16_t* Sx, const float* Wsf, const float* ln_g, const float* ln_b, const float* bs, bf16_t* BR, char* lds) {
    const int tid = tid_l(), wid = tid >> 6, lane = tid & 63;
    const long row0 = (long)item * 128;
    bf16_t* sn = (bf16_t*)lds;
    for (int t = 0; t < 16; ++t) {
        const int s = wid * 16 + t;
        const u32x4 raw = *(const u32x4*)(Sx + (row0 + s) * 512 + lane * 8);
        float v[8] = {bflo(raw.x), bfhi(raw.x), bflo(raw.y), bfhi(raw.y), bflo(raw.z), bfhi(raw.z), bflo(raw.w), bfhi(raw.w)};
        float sm = 0.f;
        for (int j = 0; j < 8; ++j) sm += v[j];
        const float mu = wave_sum(sm) * (1.f / 512.f);
        float q = 0.f;
        for (int j = 0; j < 8; ++j) { v[j] -= mu; q += v[j] * v[j]; }
        const float rstd = rsqrtf(wave_sum(q) * (1.f / 512.f) + EPS);
        for (int j = 0; j < 8; ++j) sn[s * 512 + lane * 8 + j] = (bf16_t)(cvt_pk_bf16(v[j] * rstd * ln_g[lane * 8 + j] + ln_b[lane * 8 + j], 0.f) & 0xffffu);
    }
    __syncthreads();
    const int c = tid, g = c >> 7;
    for (int t = 0; t < 128; ++t) {
        float acc = 0.f;
        for (int s = 0; s < 128; ++s) acc = fmaf(Wsf[((size_t)g * 128 + t) * 128 + s], bf2f(sn[s * 512 + c]), acc);
        acc += bs[g * 128 + t];
        BR[(row0 + t) * 1024 + 512 + c] = (bf16_t)(cvt_pk_bf16(bf2f(U[(row0 + t) * 512 + c]) * acc, 0.f) & 0xffffu);
    }
    __syncthreads();
}
}

__device__ __forceinline__ void p5_router(Frame& F) {
    const int gw = F.vcu * NWAVES + F.wave, NGW = F.G * NWAVES, lane = F.lane, n16 = lane & 15, kq = lane >> 4;
    const float* g = F.in[16]; const float* wr = F.in[17];
    unsigned char* H2 = (unsigned char*)(F.ws + WS_H2); float* aff = (float*)(F.ws + WS_AFF);
    constexpr int OFF_G = 65536, OFF_R = OFF_G + 4096, NBATCH = MTOK / 16;
    int bi = gw;
    u32x4 a[32];
#define P5_LOAD() do { const u32x4* xp = (const u32x4*)((const bf16_t*)(F.ws + WS_X1B) + (size_t)(16 * bi + n16) * DM + 8 * kq); \
    _Pragma("unroll") for (int t = 0; t < 32; ++t) a[t] = xp[4 * t]; } while (0)
    if (bi < NBATCH) P5_LOAD();
    for (int c = F.tid; c < 32 * 64; c += NTHREADS) {
        const int t = c >> 6, l = c & 63, n = l & 15, q = l >> 4, k0 = 32 * t + 8 * q;
        float w[8], lo[8];
#pragma unroll
        for (int j = 0; j < 8; ++j) { w[j] = g[k0 + j] * wr[(size_t)(k0 + j) * 16 + n]; lo[j] = w[j] - bf2f((unsigned short)att::bf16_bits(w[j])); }
        u32x4 h4, l4;
        h4.x = pk2(w[0], w[1]); h4.y = pk2(w[2], w[3]); h4.z = pk2(w[4], w[5]); h4.w = pk2(w[6], w[7]);
        l4.x = pk2(lo[0], lo[1]); l4.y = pk2(lo[2], lo[3]); l4.z = pk2(lo[4], lo[5]); l4.w = pk2(lo[6], lo[7]);
        *(LAS u32x4*)(F.lds + (t * 2 + 0) * 1024 + l * 16) = h4;
        *(LAS u32x4*)(F.lds + (t * 2 + 1) * 1024 + l * 16) = l4;
    }
    for (int c = F.tid; c < DM / 4; c += NTHREADS) *(LAS f32x4*)(F.lds + OFF_G + c * 16) = *(const f32x4*)(g + c * 4);
    __syncthreads();
    while (bi < NBATCH) {
        const int r0 = 16 * bi;
        const LAS u32x4* wl = (const LAS u32x4*)F.lds + lane; asm volatile("" : "+v"(wl));
        f32x4 chi = {0.f, 0.f, 0.f, 0.f}, clo = {0.f, 0.f, 0.f, 0.f}; float ss = 0.f;
        u32x4 bh = wl[0], bl = wl[64];
#pragma unroll
        for (int t = 0; t < 32; ++t) {
            u32x4 nh = bh, nl = bl;
            if (t < 31) { nh = wl[(t * 2 + 2) * 64]; nl = wl[(t * 2 + 3) * 64]; }
            chi = __builtin_amdgcn_mfma_f32_16x16x32_bf16(__builtin_bit_cast(bf16x8, a[t]), __builtin_bit_cast(bf16x8, bh), chi, 0, 0, 0);
            clo = __builtin_amdgcn_mfma_f32_16x16x32_bf16(__builtin_bit_cast(bf16x8, a[t]), __builtin_bit_cast(bf16x8, bl), clo, 0, 0, 0);
            ss += att::sumsq8(a[t]);
            bh = nh; bl = nl;
            SBAR();
        }
        int l2 = threadIdx.x; asm volatile("" : "+v"(l2)); l2 &= 63;
        const int n16 = l2 & 15, kq = l2 >> 4;
        ss += swz_xor<16>(ss);
        { auto rr = __builtin_amdgcn_permlane32_swap(__float_as_uint(ss), __float_as_uint(ss), false, false); ss = __uint_as_float(rr[0]) + __uint_as_float(rr[1]); }
        const float r = rsqrtf(ss * (1.f / DM) + EPS);
        LAS float* rl = (LAS float*)(F.lds + OFF_R) + F.wave * 16;
        if (kq == 0) rl[n16] = r;
        asm volatile("s_waitcnt lgkmcnt(0)" ::: "memory");
        const f32x4 r4 = *(const LAS f32x4*)(rl + 4 * kq);
        asm volatile("s_waitcnt lgkmcnt(0)" ::: "memory");
#pragma unroll
        for (int i = 0; i < 4; ++i) {
            const float t = (chi[i] + clo[i]) * r4[i];
            float mx = fmaxf(t, swz_xor<1>(t)); mx = fmaxf(mx, swz_xor<2>(mx)); mx = fmaxf(mx, swz_xor<4>(mx)); mx = fmaxf(mx, swz_xor<8>(mx));
            const float ex = __builtin_amdgcn_exp2f((t - mx) * LOG2E);
            float den = ex + swz_xor<1>(ex); den += swz_xor<2>(den); den += swz_xor<4>(den); den += swz_xor<8>(den);
            aff[(size_t)(r0 + 4 * kq + i) * 16 + n16] = ex / den;
        }
        const float rs = r * MOE_HSCALE;
        unsigned char* hp = H2 + (size_t)(r0 + n16) * DM + 8 * kq;
        const LAS f32x4* gl = (const LAS f32x4*)(F.lds + OFF_G) + 2 * kq; asm volatile("" : "+v"(gl));
#pragma unroll
        for (int t = 0; t < 32; ++t) {
            const f32x4 g0 = gl[8 * t], g1 = gl[8 * t + 1]; u32x4 w = a[t]; asm volatile("" : "+v"(w));
            int p0 = 0, p1 = 0;
            p0 = __builtin_amdgcn_cvt_pk_fp8_f32(bflo(w.x) * rs * g0.x, bfhi(w.x) * rs * g0.y, p0, false); p0 = __builtin_amdgcn_cvt_pk_fp8_f32(bflo(w.y) * rs * g0.z, bfhi(w.y) * rs * g0.w, p0, true);
            p1 = __builtin_amdgcn_cvt_pk_fp8_f32(bflo(w.z) * rs * g1.x, bfhi(w.z) * rs * g1.y, p1, false); p1 = __builtin_amdgcn_cvt_pk_fp8_f32(bflo(w.w) * rs * g1.z, bfhi(w.w) * rs * g1.w, p1, true);
            u32x2 o; o.x = (unsigned)p0; o.y = (unsigned)p1; *(u32x2*)(hp + 32 * t) = o;
            SBAR();
        }
        bi += NGW;
        if (bi < NBATCH) P5_LOAD();
    }
#undef P5_LOAD
    __syncthreads();
}

__device__ __forceinline__ void p6_topk(Frame& F, int first) {
    LAS unsigned* hist = (LAS unsigned*)F.lds;
    LAS unsigned* shv = (LAS unsigned*)(F.lds + 1024);
    const float* aff = (const float*)(F.ws + WS_AFF);
    int* idx = (int*)(F.ws + WS_IDX); float* gv = (float*)(F.ws + WS_GV); int* inv = (int*)(F.ws + WS_INV);
    const int tid = F.tid, lane = F.lane, w = F.wave;
    for (int item = first; item < NB * NE; item += F.G) {
        const int b = item >> 4, e = item & 15;
        unsigned key[8];
#pragma unroll
        for (int i = 0; i < 8; ++i) key[i] = __float_as_uint(aff[((size_t)b * SEQ + tid * 8 + i) * 16 + e]);
        unsigned prefix = 0, remain = CAP;
        for (int pass = 0; pass < 4; ++pass) {
            const int shift = 24 - 8 * pass;
            if (tid < 256) hist[tid] = 0;
            __syncthreads();
            const unsigned himask = pass == 0 ? 0u : (0xFFFFFFFFu << (shift + 8));
#pragma unroll
            for (int i = 0; i < 8; ++i) if ((key[i] & himask) == prefix) atomicAdd((unsigned*)&hist[(key[i] >> shift) & 255u], 1u);
            __syncthreads();
            if (w == 0) {
                const unsigned h0 = hist[4 * lane], h1 = hist[4 * lane + 1], h2 = hist[4 * lane + 2], h3 = hist[4 * lane + 3];
                const unsigned t = h0 + h1 + h2 + h3; unsigned v = t;
#pragma unroll
                for (int o = 1; o < 64; o <<= 1) { const unsigned n = __shfl_down(v, o); if (lane + o < 64) v += n; }
                unsigned above = v - t;
                const unsigned hh[4] = {h0, h1, h2, h3};
#pragma unroll
                for (int q = 3; q >= 0; --q) { if (above < remain && above + hh[q] >= remain) { shv[0] = prefix | ((unsigned)(4 * lane + q) << shift); shv[1] = remain - above; } above += hh[q]; }
            }
            __syncthreads();
            prefix = shv[0]; remain = shv[1];
            __syncthreads();
        }
        const unsigned T = prefix;
        unsigned ngt = 0, neq = 0;
#pragma unroll
        for (int i = 0; i < 8; ++i) { ngt += key[i] > T; neq += key[i] == T; }
        unsigned pg = ngt, pe = neq;
#pragma unroll
        for (int o = 1; o < 64; o <<= 1) { const unsigned a = __shfl_up(pg, o), c = __shfl_up(pe, o); if (lane >= o) { pg += a; pe += c; } }
        if (lane == 63) { shv[8 + w] = pg; shv[16 + w] = pe; }
        __syncthreads();
        unsigned bg = 0, be = 0;
        for (int i = 0; i < w; ++i) { bg += shv[8 + i]; be += shv[16 + i]; }
        unsigned eg = bg + pg - ngt, ee = be + pe - neq;
#pragma unroll
        for (int i = 0; i < 8; ++i) {
            const int s = tid * 8 + i;
            int slot = -1;
            if (key[i] > T) { slot = (int)(eg + min(ee, remain)); ++eg; }
            else if (key[i] == T) { if (ee < remain) slot = (int)(eg + ee); ++ee; }
            inv[((size_t)b * SEQ + s) * 16 + e] = slot;
            if (slot >= 0) { idx[item * CAP + slot] = s; gv[item * CAP + slot] = __uint_as_float(key[i]); }
        }
        __syncthreads();
    }
}

__device__ __forceinline__ void p9_final(Frame& F, float* dst) {
    const int gw = F.vcu * NWAVES + F.wave, NGW = F.G * NWAVES, lane = F.lane;
    const float* g = F.in[21]; const unsigned char* Y = (const unsigned char*)(F.ws + WS_Y); const int* inv = (const int*)(F.ws + WS_INV);
    f32x4 gg[4];
#pragma unroll
    for (int j = 0; j < 4; ++j) gg[j] = *(const f32x4*)(g + (lane + 64 * j) * 4);
    u32x2 nx[4]; int nslot = -1;
#define P9_PREF(row) do { const u32x2* xr_ = (const u32x2*)((const bf16_t*)(F.ws + WS_X1B) + (size_t)(row) * DM) + lane; \
    _Pragma("unroll") for (int j = 0; j < 4; ++j) nx[j] = xr_[64 * j]; nslot = lane < 16 ? inv[(size_t)(row) * 16 + lane] : -1; } while (0)
    if (gw < MTOK) P9_PREF(gw);
    for (int row = gw; row < MTOK; row += NGW) {
        f32x4 v[4];
#pragma unroll
        for (int j = 0; j < 4; ++j) v[j] = (f32x4){bflo(nx[j].x), bfhi(nx[j].x), bflo(nx[j].y), bfhi(nx[j].y)};
        const int myslot = nslot;
        if (row + NGW < MTOK) P9_PREF(row + NGW);
        const int b = row >> 12;
        unsigned long long mask = __ballot(myslot >= 0);
        const unsigned char* Yb = Y + (size_t)b * NE * CAP * DM;
        while (mask) {
            const int e0 = (int)__builtin_ctzll(mask); mask &= mask - 1;
            const int e1 = mask ? (int)__builtin_ctzll(mask) : e0; const bool two = mask != 0; mask &= mask - 1;
            const int s0 = __builtin_amdgcn_readlane(myslot, e0), s1 = __builtin_amdgcn_readlane(myslot, e1);
            const int* y0 = (const int*)(Yb + ((size_t)e0 * CAP + s0) * DM) + lane; const int* y1 = (const int*)(Yb + ((size_t)e1 * CAP + s1) * DM) + lane;
            int t0[4], t1[4];
#pragma unroll
            for (int j = 0; j < 4; ++j) { t0[j] = y0[64 * j]; t1[j] = y1[64 * j]; }
            const float sc1 = two ? 1.f / MOE_YSCALE : 0.f;
#pragma unroll
            for (int j = 0; j < 4; ++j) {
                const f32x2 lo = __builtin_amdgcn_cvt_pk_f32_fp8(t0[j], false), hi = __builtin_amdgcn_cvt_pk_f32_fp8(t0[j], true);
                v[j].x = fmaf(lo.x, 1.f / MOE_YSCALE, v[j].x); v[j].y = fmaf(lo.y, 1.f / MOE_YSCALE, v[j].y); v[j].z = fmaf(hi.x, 1.f / MOE_YSCALE, v[j].z); v[j].w = fmaf(hi.y, 1.f / MOE_YSCALE, v[j].w);
                const f32x2 lo1 = __builtin_amdgcn_cvt_pk_f32_fp8(t1[j], false), hi1 = __builtin_amdgcn_cvt_pk_f32_fp8(t1[j], true);
                v[j].x = fmaf(lo1.x, sc1, v[j].x); v[j].y = fmaf(lo1.y, sc1, v[j].y); v[j].z = fmaf(hi1.x, sc1, v[j].z); v[j].w = fmaf(hi1.y, sc1, v[j].w);
            }
        }
        float s = 0.f;
#pragma unroll
        for (int j = 0; j < 4; ++j) s += (v[j].x * v[j].x + v[j].y * v[j].y) + (v[j].z * v[j].z + v[j].w * v[j].w);
        const float r = rsqrtf(wave_sum(s) * (1.f / DM) + EPS);
        f32x4* xw = (f32x4*)(dst + (size_t)row * DM) + lane;
#pragma unroll
        for (int j = 0; j < 4; ++j) { f32x4 w = {v[j].x * r * gg[j].x, v[j].y * r * gg[j].y, v[j].z * r * gg[j].z, v[j].w * r * gg[j].w}; xw[64 * j] = w; }
    }
#undef P9_PREF
}

__global__ void __launch_bounds__(NTHREADS, 2) fwd_kernel(Args args) {
    extern __shared__ __attribute__((aligned(16))) unsigned char lds[];
    Frame F;
    F.lds = (LAS unsigned char*)lds; F.ldsg = lds;
    F.tid = threadIdx.x; F.lane = F.tid & 63; F.wave = __builtin_amdgcn_readfirstlane(F.tid >> 6);
    F.G = gridDim.x; { const int bx = blockIdx.x; F.vcu = (F.G % 8 == 0) ? (bx % 8) * (F.G / 8) + bx / 8 : bx; }
#pragma unroll
    for (int i = 0; i < 22; ++i) F.in[i] = args.in[i];
    F.out = args.out; F.ws = args.ws;
    volatile LAS unsigned* MISC = (volatile LAS unsigned*)(F.lds + MISC_OFF);
    for (int u = F.tid; u < (LDS_BYTES - LDSCTL_OFF) / 4; u += NTHREADS) ((LAS unsigned*)(F.lds + LDSCTL_OFF))[u] = 0u;
    __syncthreads();
    unsigned* ctl = (unsigned*)(F.ws + WS_CTL);
    const int lo = args.ph_lo, hi = args.ph_hi;
    XcdBarrier bar; bar.bar = ctl + CW_BAR; bar.x = 0; bar.st = nullptr;
    if (hi - lo > 1) {
        if (F.tid == 0 && xb_xcc_id() != ((unsigned)blockIdx.x & 7u)) atomicOr(ctl + CW_BAR + XB_MISPLACED, 1u);
        bar = xcd_barrier_post(ctl + CW_BAR, MISC + 8);
    }
#ifndef PHASE_MASK
#define PHASE_MASK 0x3ff
#endif
#define IN(k) (((PHASE_MASK >> (k)) & 1) && lo <= (k) && (k) < hi)
#define REFRESH() do { int t_ = threadIdx.x; asm volatile("" : "+v"(t_)); F.tid = t_; F.lane = t_ & 63; F.wave = __builtin_amdgcn_readfirstlane(t_ >> 6); } while (0)
#ifndef XCC_LOCAL_SEAMS
#define XCC_LOCAL_SEAMS 0
#endif
#define SEAM(k) do { if (IN(k) && IN((k) + 1)) xcd_barrier(bar); } while (0)
#define SEAML(k) do { if (IN(k) && IN((k) + 1)) { if (fastx) xcd_local_barrier(bar); else xcd_barrier(bar); } } while (0)

    bf16_t* XN = (bf16_t*)((unsigned char*)F.out + DO_XN);
    bf16_t* BR = (bf16_t*)((unsigned char*)F.out + DO_BR);
    bf16_t* Qb = (bf16_t*)(F.ws + WS_Q); bf16_t* Kb = (bf16_t*)(F.ws + WS_K); bf16_t* Vb = (bf16_t*)(F.ws + WS_V);
    bf16_t* Ub = (bf16_t*)(F.ws + WS_U); bf16_t* Sb = (bf16_t*)(F.ws + WS_S); bf16_t* GT = (bf16_t*)(F.ws + WS_GATES);

    if (IN(0)) { REFRESH(); p0_prologue(F); if (PROBE_REPEAT & 1) { __syncthreads(); p0_prologue(F); } }
    SEAM(0);
    bool fastx = false;
    if (IN(0) && IN(1)) {
        if (F.tid == 0) MISC[11] = (F.G == 256 && xb_ld(ctl + CW_BAR + XB_MISPLACED) == 0u) ? 1u : 0u;
        __syncthreads();
        fastx = XCC_LOCAL_SEAMS && MISC[11] != 0u;
    }
    if (IN(1)) {
        REFRESH();
        pg8::SchedDense S; S.init(MTOK / 256, 2560 / 256, F.G, (int)blockIdx.x); S.A = (const char*)XN; S.B = (const char*)(F.ws + WS_WCAT); S.tstep = 256u * DM * 2u;
        pg8::EpiProj E{Qb, GT, F.in[4], (float*)(F.ws + WS_KN2)};
        pg8::SchedDense S8; S8.init(MTOK / 256, 2048 / 256, F.G, (int)blockIdx.x); S8.A = (const char*)F.out + DO_XN8; S8.B = (const char*)(F.ws + WS_WG8); S8.tstep = 256u * DM;
        pg8::EpiGate E8{GT, F.in[4]};
#if USE_NAIVE_GEMM
        pg8::gemm_phase_naive<pg8::EpiProj, pg8::SchedDense, false, false>(DM, S, E);
#else
        pg8::gemm_phase<pg8::EpiProj, pg8::SchedDense, true, false, false>(F.lds, DM * 2, S, E);
        pg8::gemm_phase<pg8::EpiGate, pg8::SchedDense, true, false, false, true>(F.lds, DM, S8, E8);
        if (PROBE_REPEAT & 2) pg8::gemm_phase<pg8::EpiProj, pg8::SchedDense, true, false, false>(F.lds, DM * 2, S, E);
#endif
    }
    SEAML(1);
    if (IN(2)) {
        REFRESH();
        const float a1 = wave_sum(F.in[5][F.lane] * F.in[6][F.lane]), a2 = wave_sum(F.in[7][F.lane] * F.in[8][F.lane]);
        const float lam = __uint_as_float(__builtin_amdgcn_readfirstlane(__float_as_uint(expf(a1) - expf(a2) + 0.2f)));
#if USE_NAIVE_ATTN
        att::attn_naive(F, Qb, Kb, Vb, BR, F.in[9], lam);
#else
        float* park = (float*)((unsigned char*)F.out + DO_PARK) + (size_t)blockIdx.x * (NWAVES * 64 * 64);
        for (int rep = 0; rep < ((PROBE_REPEAT & 4) ? 2 : 1); ++rep)
        for (int v = F.vcu; v < NB * 32; v += F.G)
            for (int i = 0; i < 2; ++i) {
                int vv = v * 2 + i; asm volatile("" : "+s"(vv));
                const int vq = vv >> 1, ii = vv & 1, b = vq >> 5, pr = (vq >> 4) & 1, qb = vq & 15, h = ii == 0 ? (pr ? 2 : 3) : (pr ? 1 : 0);
                att::attn_unit(b, h, qb, Qb, Kb, Vb, (const float*)(F.ws + WS_KN2), BR, park, F.in[9], lam, (char*)lds);
            }
        if (F.G == 256 && ((F.vcu >> 4) & 1) == 0) {
            REFRESH();
            const int w30 = (F.vcu >> 5) * 16 + (F.vcu & 15);
            LAS float* scr = (LAS float*)(F.lds + F.wave * 16384);
            for (int r = w30 * NWAVES + F.wave; r < EXP_P2_ITEMS; r += 128 * NWAVES) expert_item(F, r, scr);
            __syncthreads();
        } else if (F.G != 256) { REFRESH(); LAS float* scr = (LAS float*)(F.lds + F.wave * 16384); for (int r = F.vcu * NWAVES + F.wave; r < EXP_P2_ITEMS; r += F.G * NWAVES) expert_item(F, r, scr); __syncthreads(); }
#endif
        REFRESH();
        for (int rep2 = 0; rep2 < ((PROBE_REPEAT & 1024) ? 2 : 1); ++rep2)
        for (int it = F.vcu; it < MTOK / 128; it += F.G) {
#if USE_NAIVE_SGU
            att::sgu_naive(it, Ub, Sb, F.in[12], F.in[10], F.in[11], F.in[13], BR, (char*)lds);
#else
            att::sgu_item(it, Ub, Sb, (const bf16_t*)(F.ws + WS_WSGU), F.in[10], F.in[11], F.in[13], BR, (char*)lds);
#endif
        }
    }
    SEAML(2);
    if (IN(3)) {
        REFRESH();
        pg8::SchedDense S; S.init(MTOK / 256, DM / 256, F.G, (int)blockIdx.x); S.A = (const char*)BR; S.B = (const char*)(F.ws + WS_WBR); S.tstep = 256u * DM * 2u;
        pg8::EpiMix E{GT, (bf16_t*)(F.ws + WS_MIXED)};
#if USE_NAIVE_GEMM
        pg8::gemm_phase_naive<pg8::EpiMix, pg8::SchedDense, false, true>(DM, S, E);
#else
        pg8::gemm_phase<pg8::EpiMix, pg8::SchedDense, true, false, true>(F.lds, DM * 2, S, E);
        if (PROBE_REPEAT & 8) pg8::gemm_phase<pg8::EpiMix, pg8::SchedDense, true, false, true>(F.lds, DM * 2, S, E);
#endif
    }
    SEAM(3);
    if (IN(4)) {
        REFRESH();
        pg8::SchedDense S; S.init(MTOK / 256, DM / 256, F.G, (int)blockIdx.x); S.A = (const char*)(F.ws + WS_MIXED); S.B = (const char*)(F.ws + WS_WOUT); S.tstep = 256u * DM * 2u;
        pg8::EpiRes E{F.in[0], (bf16_t*)(F.ws + WS_X1B)};
#if USE_NAIVE_GEMM
        pg8::gemm_phase_naive<pg8::EpiRes, pg8::SchedDense, false, false>(DM, S, E);
#else
        pg8::gemm_phase<pg8::EpiRes, pg8::SchedDense, true, false, false>(F.lds, DM * 2, S, E);
        if (PROBE_REPEAT & 16) pg8::gemm_phase<pg8::EpiRes, pg8::SchedDense, true, false, false>(F.lds, DM * 2, S, E);
#endif
    }
    SEAML(4);
    if (IN(5)) { REFRESH(); p5_router(F); if (PROBE_REPEAT & 32) p5_router(F); }
    SEAML(5);
    if (PROBE_REPEAT & 2048) { for (int i_ = 0; i_ < 10; ++i_) SEAM(5); }
    if (PROBE_REPEAT & 4096) { for (int i_ = 0; i_ < 10; ++i_) SEAML(5); }
    const int p6_first = fastx ? ((F.vcu & 31) < 16 ? (F.vcu >> 5) * 16 + (F.vcu & 31) : NB * NE) : F.vcu;
    if (IN(6)) { REFRESH(); p6_topk(F, p6_first); if (PROBE_REPEAT & 64) p6_topk(F, p6_first);
        { REFRESH();
          LAS float* scr = (LAS float*)(F.lds + 16384 + F.wave * 8704);
          if (F.G == 256) {
              const bool idle = p6_first >= NB * NE;
              const int me = idle ? (fastx ? (F.vcu >> 5) * 16 + (F.vcu & 31) - 16 : F.vcu - NB * NE) : p6_first;
              constexpr int SPLIT = EXP_P6_ITEMS * 5 / 8;
              const int lo_ = EXP_P2_ITEMS + (idle ? 0 : SPLIT), hi_ = EXP_P2_ITEMS + (idle ? SPLIT : EXP_P6_ITEMS);
              for (int r = lo_ + me * NWAVES + F.wave; r < hi_; r += 128 * NWAVES) expert_item(F, r, scr);
          } else {
              const int nidle = F.G > NB * NE ? F.G - NB * NE : F.G, me = F.G > NB * NE ? F.vcu - NB * NE : F.vcu;
              if (me >= 0) for (int r = EXP_P2_ITEMS + me * NWAVES + F.wave; r < EXP_P2_ITEMS + EXP_P6_ITEMS; r += nidle * NWAVES) expert_item(F, r, scr); } } }
    SEAM(6);
    if (IN(7)) {
        REFRESH();
        pg8::SchedMoe S; S.init(MROWS / 256, 4096 / 256, F.G, (int)blockIdx.x);
        S.A = (const char*)(F.ws + WS_H2); S.B = (const char*)(F.ws + WS_WGU); S.idx = (const int*)(F.ws + WS_IDX);
        S.a_bstride = (unsigned)SEQ * DM; S.a_rowbytes = 0; S.b_estride = 4096u * DM; S.b_tstep = 256u * DM; S.gather = true;
        pg8::EpiSwiglu E{(unsigned char*)(F.ws + WS_ACT)};
#if 1
        pg8::gemm_phase<pg8::EpiSwiglu, pg8::SchedMoe, true, true, false, true>(F.lds, DM, S, E);
        if (PROBE_REPEAT & 128) pg8::gemm_phase<pg8::EpiSwiglu, pg8::SchedMoe, true, true, false, true>(F.lds, DM, S, E);
#endif
    }
    SEAML(7);
    if (IN(8)) {
        REFRESH();
        pg8::SchedMoe S; S.init(MROWS / 256, DM / 256, F.G, (int)blockIdx.x);
        S.A = (const char*)(F.ws + WS_ACT); S.B = (const char*)(F.ws + WS_WD); S.idx = nullptr;
        S.a_bstride = 0; S.a_rowbytes = (unsigned)FF; S.b_estride = (unsigned)DM * FF; S.b_tstep = 256u * FF; S.gather = false;
        pg8::EpiDown E{(const float*)(F.ws + WS_GV), (unsigned char*)(F.ws + WS_Y)};
#if 1
        pg8::gemm_phase<pg8::EpiDown, pg8::SchedMoe, true, false, false, true>(F.lds, FF, S, E);
        if (PROBE_REPEAT & 256) pg8::gemm_phase<pg8::EpiDown, pg8::SchedMoe, true, false, false, true>(F.lds, FF, S, E);
#endif
    }
    SEAM(8);
    if (IN(9)) { REFRESH(); if (PROBE_REPEAT & 512) p9_final(F, (float*)(F.ws + WS_ACT)); p9_final(F, F.out); }
#undef IN
#undef SEAM
}

extern "C" void kernel_launch(void* const* d_in, const int* in_sizes, int n_in, void* d_out, int out_size, void* d_ws, size_t ws_size, hipStream_t stream) {
    static int grid = 0;
    if (grid == 0) {
        if (n_in != 22 || in_sizes[0] != MTOK * DM || out_size != MTOK * DM || ws_size < WS_END) { fprintf(stderr, "kernel_launch: shape/workspace mismatch (n_in %d, ws %zu)\n", n_in, ws_size); grid = -1; return; }
        int dev = 0, cus = 0;
        if (hipGetDevice(&dev) != hipSuccess || hipDeviceGetAttribute(&cus, hipDeviceAttributeMultiprocessorCount, dev) != hipSuccess) { grid = -1; return; }
        if (hipFuncSetAttribute((const void*)fwd_kernel, hipFuncAttributeMaxDynamicSharedMemorySize, LDS_BYTES) != hipSuccess) { fprintf(stderr, "kernel_launch: hipFuncSetAttribute failed\n"); grid = -1; return; }
        int per_cu = 0;
        if (hipOccupancyMaxActiveBlocksPerMultiprocessor(&per_cu, (const void*)fwd_kernel, NTHREADS, LDS_BYTES) != hipSuccess || per_cu < 1) fprintf(stderr, "kernel_launch: occupancy query reports %d\n", per_cu);
        (void)hipGetLastError();
        grid = cus;
    }
    if (grid < 0) return;
    if (hipMemsetAsync((char*)d_ws + WS_CTL, 0, CTL_ZERO_BYTES, stream) != hipSuccess) return;
    Args a{};
    for (int i = 0; i < 22; ++i) a.in[i] = (const float*)d_in[i];
    a.out = (float*)d_out; a.ws = (unsigned char*)d_ws;
    if (MK_N_LAUNCHES == 1) { a.ph_lo = 0; a.ph_hi = NPHASE; hipLaunchKernelGGL(fwd_kernel, dim3(grid), dim3(NTHREADS), LDS_BYTES, stream, a); }
    else for (int p = 0; p < NPHASE; ++p) { a.ph_lo = p; a.ph_hi = p + 1; hipLaunchKernelGGL(fwd_kernel, dim3(grid), dim3(NTHREADS), LDS_BYTES, stream, a); }
}
```

```cpp
#include <hip/hip_runtime.h>
#include <cstdint>
#include <cstdio>
#include <cmath>

#ifndef MK_N_LAUNCHES
#define MK_N_LAUNCHES 1
#endif
#ifndef PROBE_REPEAT
#define PROBE_REPEAT 0
#endif
#ifndef USE_NAIVE_GEMM
#define USE_NAIVE_GEMM 0
#endif
#ifndef USE_NAIVE_ATTN
#define USE_NAIVE_ATTN 0
#endif
#ifndef USE_NAIVE_SGU
#define USE_NAIVE_SGU 0
#endif

#define GAS __attribute__((address_space(1)))
#define LAS __attribute__((address_space(3)))
typedef unsigned short bf16_t;
typedef short bf16x8 __attribute__((ext_vector_type(8)));
typedef short s16x4 __attribute__((ext_vector_type(4)));
typedef float f32x2 __attribute__((ext_vector_type(2)));
typedef float f32x4 __attribute__((ext_vector_type(4)));
typedef float f32x16 __attribute__((ext_vector_type(16)));
typedef unsigned u32x2 __attribute__((ext_vector_type(2)));
typedef unsigned u32x4 __attribute__((ext_vector_type(4)));

constexpr int NB = 8, SEQ = 4096, DM = 1024, MTOK = NB * SEQ;
constexpr int NCAT = 4608;
constexpr int NE = 16, CAP = 512, FF = 2048, MROWS = NB * NE * CAP;
constexpr float EPS = 1e-6f;
constexpr float LOG2E = 1.4426950408889634f;
constexpr float MOE_WSCALE = 64.f, MOE_HSCALE = 4.f, MOE_ASCALE = 8.f, MOE_YSCALE = 32.f;
constexpr float C2 = 0.125f * LOG2E;
constexpr int NWAVES = 8, NTHREADS = 512;
constexpr int NPHASE = 10;

constexpr size_t MiB = 1u << 20, KiB = 1u << 10;
constexpr size_t WS_CTL = 0, CTL_ZERO_BYTES = 1 * MiB;
constexpr size_t WS_WCAT = 2 * MiB;
constexpr size_t WS_WG8 = 7 * MiB;
constexpr size_t WS_WBR = 11 * MiB;
constexpr size_t WS_WOUT = 13 * MiB;
constexpr size_t WS_WSGU = 15 * MiB;
constexpr size_t WS_AFF = 16 * MiB;
constexpr size_t WS_IDX = 18 * MiB;
constexpr size_t WS_GV = 18 * MiB + 256 * KiB;
constexpr size_t WS_INV = 19 * MiB;
constexpr size_t WS_KN2 = 21 * MiB;
constexpr size_t WS_WGU = 22 * MiB;
constexpr size_t WS_WD = 150 * MiB;
constexpr size_t WS_Q = 214 * MiB, WS_K = 246 * MiB, WS_V = 278 * MiB, WS_U = 310 * MiB, WS_S = 342 * MiB;
constexpr size_t WS_GATES = 374 * MiB;
constexpr size_t WS_MIXED = 86 * MiB;
constexpr size_t WS_ACT = 214 * MiB;
constexpr size_t WS_H2 = 470 * MiB;
constexpr size_t WS_X1B = 374 * MiB;
constexpr size_t WS_Y = 86 * MiB;
constexpr size_t WS_END = 534 * MiB;
constexpr size_t DO_XN = 0;
constexpr size_t DO_BR = 0;
constexpr size_t DO_XN8 = 96 * MiB;
constexpr size_t DO_PARK = 64 * MiB;
constexpr int CW_BAR = 4096;

constexpr int RING_BYTES = 131072, LDS_BYTES = 147456, LDSCTL_OFF = LDS_BYTES - 512, MISC_OFF = LDSCTL_OFF + 320;

#define LDS_WAIT() asm volatile("s_waitcnt lgkmcnt(0)" ::: "memory")
#define VM_WAIT() asm volatile("s_waitcnt vmcnt(0)" ::: "memory")
#define SBAR() __builtin_amdgcn_sched_barrier(0)
__device__ __forceinline__ int tid_l() { int t_ = threadIdx.x; asm volatile("" : "+v"(t_)); return t_; }
typedef float f32x2v_t __attribute__((ext_vector_type(2))); typedef __bf16 bf16x2v_t __attribute__((ext_vector_type(2)));
__device__ __forceinline__ unsigned cvt_pk_bf16(float lo, float hi) { const f32x2v_t v = {lo, hi}; const bf16x2v_t b = __builtin_convertvector(v, bf16x2v_t); return __builtin_bit_cast(unsigned, b); }
__device__ __forceinline__ float bf2f(unsigned short b) { return __uint_as_float(((unsigned)b) << 16); }
__device__ __forceinline__ float bflo(unsigned w) { return __uint_as_float(w << 16); }
__device__ __forceinline__ float bfhi(unsigned w) { return __uint_as_float(w & 0xffff0000u); }
template <int X> __device__ __forceinline__ float swz_xor(float v) { return __int_as_float(__builtin_amdgcn_ds_swizzle(__float_as_int(v), (X << 10) | 0x1f)); }
__device__ __forceinline__ float half_sum(float v) { v += swz_xor<1>(v); v += swz_xor<2>(v); v += swz_xor<4>(v); v += swz_xor<8>(v); v += swz_xor<16>(v); return v; }
__device__ __forceinline__ float half_max(float v) { v = fmaxf(v, swz_xor<1>(v)); v = fmaxf(v, swz_xor<2>(v)); v = fmaxf(v, swz_xor<4>(v)); v = fmaxf(v, swz_xor<8>(v)); v = fmaxf(v, swz_xor<16>(v)); return v; }
__device__ __forceinline__ float wave_sum(float v) { v = half_sum(v); return __int_as_float(__builtin_amdgcn_readlane(__float_as_int(v), 0)) + __int_as_float(__builtin_amdgcn_readlane(__float_as_int(v), 32)); }
__device__ __forceinline__ float wave_max(float v) { v = half_max(v); return fmaxf(__int_as_float(__builtin_amdgcn_readlane(__float_as_int(v), 0)), __int_as_float(__builtin_amdgcn_readlane(__float_as_int(v), 32))); }
__device__ __forceinline__ f32x2 gelu_pk(f32x2 v) {
    const f32x2 av = __builtin_elementwise_abs(v), d = av * 0.2316418882f + 1.0f;
    f32x2 t; t.x = __builtin_amdgcn_rcpf(d.x); t.y = __builtin_amdgcn_rcpf(d.y);
    f32x2 q = t * 0.5307027145f + (-0.7265760135f); q = q * t + 0.7107068705f; q = q * t + (-0.142248368f); q = q * t + 0.127414796f; q = q * t;
    const f32x2 s = (v * v) * (-0.72134752044f);
    f32x2 e; e.x = __builtin_amdgcn_exp2f(s.x); e.y = __builtin_amdgcn_exp2f(s.y);
    const f32x2 m = v * (q * e), r = v - m;
    f32x2 o; o.x = v.x < 0.f ? m.x : r.x; o.y = v.y < 0.f ? m.y : r.y; return o;
}
__device__ __forceinline__ void gelu8(f32x4& v0, f32x4& v1) {
    float v[8] = {v0[0], v0[1], v0[2], v0[3], v1[0], v1[1], v1[2], v1[3]}, t[8], q[8], e[8];
#pragma unroll
    for (int i = 0; i < 8; ++i) t[i] = __builtin_amdgcn_rcpf(fmaf(fabsf(v[i]), 0.2316418882f, 1.0f));
#pragma unroll
    for (int i = 0; i < 8; ++i) e[i] = __builtin_amdgcn_exp2f((v[i] * v[i]) * (-0.72134752044f));
#pragma unroll
    for (int i = 0; i < 8; ++i) q[i] = fmaf(t[i], 0.5307027145f, -0.7265760135f);
#pragma unroll
    for (int i = 0; i < 8; ++i) q[i] = fmaf(q[i], t[i], 0.7107068705f);
#pragma unroll
    for (int i = 0; i < 8; ++i) q[i] = fmaf(q[i], t[i], -0.142248368f);
#pragma unroll
    for (int i = 0; i < 8; ++i) q[i] = fmaf(q[i], t[i], 0.127414796f);
#pragma unroll
    for (int i = 0; i < 8; ++i) q[i] = (q[i] * t[i]) * e[i];
#pragma unroll
    for (int i = 0; i < 8; ++i) v[i] = fmaf(-fabsf(v[i]), q[i], fmaxf(v[i], 0.f));
    v0 = (f32x4){v[0], v[1], v[2], v[3]}; v1 = (f32x4){v[4], v[5], v[6], v[7]};
}
__device__ __forceinline__ float sigmoidf_(float x) { return __builtin_amdgcn_rcpf(1.f + __builtin_amdgcn_exp2f(-LOG2E * x)); }

#define XB_TMO      128
#define XB_XCNT(j)  (256  + 64 * (j))
#define XB_XSUB(j)  (1280 + 64 * (j))
#define XB_XGEN(j)  (2304 + 64 * (j))
#define XB_TOP      3328
#define XB_TOPGEN   3392
#define XCD_BAR_WORDS 3456
#define XB_SPIN_CAP (1u << 18)
__device__ __forceinline__ unsigned xb_ld(unsigned* p)              { return __hip_atomic_load(p, __ATOMIC_RELAXED, __HIP_MEMORY_SCOPE_AGENT); }
__device__ __forceinline__ unsigned xb_add(unsigned* p, unsigned v) { return __hip_atomic_fetch_add(p, v, __ATOMIC_RELAXED, __HIP_MEMORY_SCOPE_AGENT); }
__device__ __forceinline__ unsigned xb_xcc_id() { return (unsigned)__builtin_amdgcn_s_getreg((3 << 11) | 20) & 0xFu; }
#define XB_SPIN(cond, bar) do { unsigned _sp = 0; while (cond) { __builtin_amdgcn_s_sleep(1); \
    if ((++_sp & 255u) == 0u) { if (xb_ld(&(bar)[XB_TMO])) break; if (_sp > XB_SPIN_CAP) { atomicAdd(&(bar)[XB_TMO], 1u); break; } } } } while (0)
struct XcdBarrier { unsigned* bar; unsigned x; volatile LAS unsigned* st; };
__device__ __forceinline__ XcdBarrier xcd_barrier_post(unsigned* bar, volatile LAS unsigned* st) {
    XcdBarrier b; b.bar = bar; b.x = xb_xcc_id(); b.st = st;
    if (threadIdx.x == 0) (void)xb_add(&bar[XB_XCNT(b.x)], 1u);
    return b;
}
__device__ __forceinline__ void xcd_barrier_complete(unsigned* bar, unsigned x, unsigned& nloc, unsigned& nx, unsigned& mask) {
    const unsigned G = gridDim.x * gridDim.y * gridDim.z;
    unsigned sum, cnt, mine, sp = 0u;
    for (;;) {
        sum = 0u; cnt = 0u; mine = 0u; mask = 0u;
#pragma unroll
        for (unsigned j = 0; j < 16; ++j) { const unsigned c = xb_ld(&bar[XB_XCNT(j)]); sum += c; cnt += (c > 0u) ? 1u : 0u; mask |= (c > 0u) ? (1u << j) : 0u; mine = (j == x) ? c : mine; }
        if (sum == G) break;
        __builtin_amdgcn_s_sleep(1);
        if ((++sp & 255u) == 0u) { if (xb_ld(&bar[XB_TMO])) break; if (sp > XB_SPIN_CAP) { atomicAdd(&bar[XB_TMO], 1u); break; } }
    }
    nloc = mine > 0u ? mine : 1u; nx = cnt > 0u ? cnt : 1u;
}
__device__ __forceinline__ void xcd_barrier(const XcdBarrier& b) {
    asm volatile("s_waitcnt vmcnt(0)" ::: "memory");
    __syncthreads();
    if (threadIdx.x == 0) {
        unsigned* bar = b.bar;
        __builtin_amdgcn_s_waitcnt(0);
        unsigned nloc = b.st[0], nx = b.st[1], mask = b.st[2];
        if (nloc == 0u) { xcd_barrier_complete(bar, b.x, nloc, nx, mask); b.st[0] = nloc; b.st[1] = nx; b.st[2] = mask; }
        const unsigned old = xb_add(&bar[XB_XSUB(b.x)], 1u);
        const unsigned gen = old / nloc;
        if (old + 1u == (gen + 1u) * nloc) {
            __builtin_amdgcn_fence(__ATOMIC_RELEASE, "agent");
            asm volatile("s_waitcnt vmcnt(0)" ::: "memory");
            const unsigned og = xb_add(&bar[XB_TOP], 1u);
            const unsigned tg = og / nx;
            if (og + 1u == (tg + 1u) * nx) {
#pragma unroll
                for (unsigned j = 0; j < 16; ++j) if ((mask >> j) & 1u) (void)xb_add(&bar[XB_XGEN(j)], 1u);
            } else XB_SPIN(xb_ld(&bar[XB_XGEN(b.x)]) == gen, bar);
            __builtin_amdgcn_fence(__ATOMIC_ACQUIRE, "agent");
            asm volatile("s_waitcnt vmcnt(0)" ::: "memory");
        } else {
            XB_SPIN(xb_ld(&bar[XB_XGEN(b.x)]) == gen, bar);
            __builtin_amdgcn_fence(__ATOMIC_ACQUIRE, "agent");
            asm volatile("s_waitcnt vmcnt(0)" ::: "memory");
        }
    }
    __syncthreads();
}

#define XB_LSUB(j)  (3456 + 64 * (j))
#define XB_LGEN(j)  (4480 + 64 * (j))
#define XB_MISPLACED 5504
__device__ __forceinline__ void xcd_local_barrier(const XcdBarrier& b) {
    asm volatile("s_waitcnt vmcnt(0)" ::: "memory");
    __syncthreads();
    if (threadIdx.x == 0) {
        unsigned* bar = b.bar;
        __builtin_amdgcn_s_waitcnt(0);
        const unsigned nloc = b.st[0];
        const unsigned old = xb_add(&bar[XB_LSUB(b.x)], 1u);
        const unsigned gen = old / nloc;
        if (old + 1u == (gen + 1u) * nloc) (void)xb_add(&bar[XB_LGEN(b.x)], 1u);
        else XB_SPIN(xb_ld(&bar[XB_LGEN(b.x)]) == gen, bar);
        __builtin_amdgcn_fence(__ATOMIC_ACQUIRE, "agent");
        asm volatile("s_waitcnt vmcnt(0)" ::: "memory");
    }
    __syncthreads();
}

namespace pg8 {
constexpr int BM = 256, BK = 64, HALF = 128, HTB = HALF * BK * 2, STAGE_BYTES = 8 * HTB, NXCD = 8, WGM = 8;
__host__ __device__ __forceinline__ int lds_byte(int r, int c) { const int st = (r >> 4) * 2 + (c >> 5), rr = r & 15, cc = c & 31, ob = rr * 64 + cc * 2; return st * 1024 + (ob ^ (((ob >> 9) & 1) << 5)); }
__host__ __device__ __forceinline__ void stage_rc(int b, int& R, int& C) { const int st = b / 1024, sb = b % 1024, swz = sb ^ (((sb >> 9) & 1) << 5); R = (st >> 1) * 16 + swz / 64; C = (st & 1) * 32 + (swz % 64) / 2; }
__host__ __device__ __forceinline__ int perm32(int rho) { const int n = rho >> 4, i = rho & 15; return 8 * (i >> 2) + 4 * n + (i & 3); }

struct Unit { int pm, pn, orow; };
struct OrderBase {
    int nM, nN, nwg, G, c;
    __device__ void init(int nM_, int nN_, int G_, int c_) { nM = nM_; nN = nN_; nwg = nM * nN; G = G_; c = c_; }
    __device__ bool next_mn(int i, int& pm, int& pn) const {
        const long L = (long)i * G + c; if (L >= nwg) return false;
        int wgid = (int)L; { const int q = nwg / NXCD, r = nwg % NXCD, xcd = wgid % NXCD, off = wgid / NXCD; wgid = (xcd < r ? xcd * (q + 1) : r * (q + 1) + (xcd - r) * q) + off; }
        const int nig = WGM * nN, gid = wgid / nig, fm = gid * WGM, gsz = (nM - fm) < WGM ? (nM - fm) : WGM;
        pm = fm + ((wgid % nig) % gsz); pn = (wgid % nig) / gsz; return true;
    }
};
struct SchedDense : OrderBase {
    const char* A; const char* B; unsigned tstep;
    __device__ bool next(int i, Unit& u) const { if (!next_mn(i, u.pm, u.pn)) return false; u.orow = u.pm * BM; return true; }
    __device__ void addr(const Unit& u, unsigned& a, unsigned& b) const { a = (unsigned)u.pm * tstep; b = (unsigned)u.pn * tstep; }
    __device__ const int* gidx(const Unit&) const { return nullptr; }
};
struct SchedMoe : OrderBase {
    const char* A; const char* B; const int* idx; unsigned a_bstride, a_rowbytes, b_estride, b_tstep; bool gather;
    __device__ bool next(int i, Unit& u) const { if (!next_mn(i, u.pm, u.pn)) return false; const int e = u.pm >> 4, b = (u.pm >> 1) & 7, h = u.pm & 1; u.orow = (b * NE + e) * CAP + h * 256; return true; }
    __device__ void addr(const Unit& u, unsigned& a, unsigned& b) const {
        const int e = u.pm >> 4, bb = (u.pm >> 1) & 7;
        a = gather ? (unsigned)bb * a_bstride : (unsigned)u.orow * a_rowbytes;
        b = (unsigned)e * b_estride + (unsigned)u.pn * b_tstep;
    }
    __device__ const int* gidx(const Unit& u) const { return idx + u.orow; }
};

#define PG8_SA(b, h) (((b) * 2 + (h)) * HTB)
#define PG8_SB(b, h) ((4 + (b) * 2 + (h)) * HTB)
#ifndef PG8_BUFSTAGE_BF16
#define PG8_BUFSTAGE_BF16 1
#endif
#define PG8_STAGE(bufoff, rs, soff, v0, v1) do { if constexpr (FP8 || PG8_BUFSTAGE_BF16) { \
        __builtin_amdgcn_raw_ptr_buffer_load_lds(rs, (LAS void*)(lds + (bufoff) + ldsw), 16, (int)(v0), (int)(soff), 0, 0); \
        __builtin_amdgcn_raw_ptr_buffer_load_lds(rs, (LAS void*)(lds + (bufoff) + ldsw + 8192), 16, (int)(v1), (int)(soff), 0, 0); } else { \
        const char* gb_ = (&rs == &rsA ? S.A : S.B) + (soff); \
        __builtin_amdgcn_global_load_lds((const unsigned*)(gb_ + (v0)), (LAS unsigned*)(lds + (bufoff) + ldsw), 16, 0, 0); \
        __builtin_amdgcn_global_load_lds((const unsigned*)(gb_ + (v1)), (LAS unsigned*)(lds + (bufoff) + ldsw + 8192), 16, 0, 0); } } while (0)
#define PG8_LDA(dst, b, h) do { if constexpr (FP8) { _Pragma("unroll") for (int m = 0; m < 4; ++m) dst##8[m] = cat8(*(const LAS bf16x8*)(lds + PG8_SA(b, h) + aoff + m * 2048), *(const LAS bf16x8*)(lds + PG8_SA(b, h) + aoff + m * 2048 + 1024)); } \
    else { _Pragma("unroll") for (int m = 0; m < 4; ++m) _Pragma("unroll") for (int k = 0; k < 2; ++k) dst[m][k] = *(const LAS bf16x8*)(lds + PG8_SA(b, h) + aoff + m * 2048 + k * 1024); } } while (0)
#define PG8_LDB(dst, b, h) do { if constexpr (FP8) { _Pragma("unroll") for (int n = 0; n < 2; ++n) dst##8[n] = cat8(*(const LAS bf16x8*)(lds + PG8_SB(b, h) + boff + n * 2048), *(const LAS bf16x8*)(lds + PG8_SB(b, h) + boff + n * 2048 + 1024)); } \
    else { _Pragma("unroll") for (int n = 0; n < 2; ++n) _Pragma("unroll") for (int k = 0; k < 2; ++k) dst[n][k] = *(const LAS bf16x8*)(lds + PG8_SB(b, h) + boff + n * 2048 + k * 1024); } } while (0)
typedef int i32x4 __attribute__((ext_vector_type(4)));
typedef int i32x8 __attribute__((ext_vector_type(8)));
__device__ __forceinline__ i32x8 cat8(bf16x8 lo, bf16x8 hi) { const i32x4 a = __builtin_bit_cast(i32x4, lo), b = __builtin_bit_cast(i32x4, hi); return __builtin_shufflevector(a, b, 0, 1, 2, 3, 4, 5, 6, 7); }
#define PG8_MMA(ai, bj, At, Bt) do { __builtin_amdgcn_s_setprio(1); \
    if constexpr (FP8) { _Pragma("unroll") for (int m = 0; m < 4; ++m) _Pragma("unroll") for (int n = 0; n < 2; ++n) \
        acc[ai][bj][m][n] = __builtin_amdgcn_mfma_scale_f32_16x16x128_f8f6f4(Bt##8[n], At##8[m], acc[ai][bj][m][n], 0, 0, 0, 0x7f7f7f7f, 0, 0x7f7f7f7f); } \
    else { _Pragma("unroll") for (int m = 0; m < 4; ++m) _Pragma("unroll") for (int n = 0; n < 2; ++n) _Pragma("unroll") for (int k = 0; k < 2; ++k) \
        acc[ai][bj][m][n] = __builtin_amdgcn_mfma_f32_16x16x32_bf16(Bt[n][k], At[m][k], acc[ai][bj][m][n], 0, 0, 0); } __builtin_amdgcn_s_setprio(0); } while (0)
#define PG8_WAIT_V(n) asm volatile("s_waitcnt vmcnt(" #n ")" ::: "memory")
#define PG8_WAIT_L(n) asm volatile("s_waitcnt lgkmcnt(" #n ")" ::: "memory")
#define PG8_BAR __builtin_amdgcn_s_barrier()
#define PG8_SCHED __builtin_amdgcn_sched_barrier(0)

template <class Epi, class Sched, bool ALIGN_EPI, bool GATHER, bool MIDHOOK, bool FP8 = false>
__device__ __forceinline__ void gemm_phase(LAS unsigned char* lds, const int RB, const Sched& S, const Epi& E) {
    const int tid = tid_l(), wid = __builtin_amdgcn_readfirstlane(tid >> 6), lane = tid & 63, wr = wid >> 2, wc = wid & 3, fr = lane & 15, fq = lane >> 4;
    const int nt = RB / (BK * 2);
    int Rs[2], Cs[2];
    unsigned voffB0, voffB1, vA[2][2], nvA[2][2];
#pragma unroll
    for (int i = 0; i < 2; ++i) stage_rc(tid * 16 + i * 8192, Rs[i], Cs[i]);
    { const int Rb0 = Epi::PERM ? ((Rs[0] & ~31) + perm32(Rs[0] & 31)) : Rs[0], Rb1 = Epi::PERM ? ((Rs[1] & ~31) + perm32(Rs[1] & 31)) : Rs[1];
      voffB0 = (unsigned)(Rb0 * RB + Cs[0] * 2); voffB1 = (unsigned)(Rb1 * RB + Cs[1] * 2); }
    const unsigned kstep = (unsigned)(BK * 2);
    const unsigned hstep = (unsigned)(HALF * RB);
    const auto rsA = __builtin_amdgcn_make_buffer_rsrc((void*)S.A, (short)0, 0x7ffffff0, 0x00020000), rsB = __builtin_amdgcn_make_buffer_rsrc((void*)S.B, (short)0, 0x7ffffff0, 0x00020000);
    const unsigned ldsw = (unsigned)wid * 1024u;
    const int aoff = lds_byte(wr * 64 + fr, fq * 8), boff = lds_byte(wc * 32 + fr, fq * 8);
    Unit cur, nxt; int ui = 0;
    if (!S.next(0, cur)) return;
    f32x4 acc[2][2][4][2];
#pragma unroll
    for (int a = 0; a < 2; ++a)
#pragma unroll
        for (int b = 0; b < 2; ++b)
#pragma unroll
            for (int m = 0; m < 4; ++m)
#pragma unroll
                for (int n = 0; n < 2; ++n) acc[a][b][m][n] = (f32x4){0.f, 0.f, 0.f, 0.f};
    bf16x8 At[4][2], B0[2][2], B1[2][2]; i32x8 At8[4], B08[2], B18[2];
    unsigned cA, cB; S.addr(cur, cA, cB);
    if constexpr (GATHER) { const int* gi = S.gidx(cur);
#pragma unroll
        for (int h = 0; h < 2; ++h)
#pragma unroll
            for (int i = 0; i < 2; ++i) vA[h][i] = (unsigned)(gi[h * HALF + Rs[i]] * RB + Cs[i] * 2);
    } else {
#pragma unroll
        for (int h = 0; h < 2; ++h)
#pragma unroll
            for (int i = 0; i < 2; ++i) vA[h][i] = (unsigned)((h * HALF + Rs[i]) * RB + Cs[i] * 2);
    }
    PG8_STAGE(PG8_SB(0, 0), rsB, cB, voffB0, voffB1); PG8_STAGE(PG8_SB(0, 1), rsB, cB + hstep, voffB0, voffB1); PG8_STAGE(PG8_SA(0, 0), rsA, cA, vA[0][0], vA[0][1]); PG8_STAGE(PG8_SA(0, 1), rsA, cA + (GATHER ? 0u : hstep), vA[GATHER ? 1 : 0][0], vA[GATHER ? 1 : 0][1]);
    if (wr == 1) PG8_BAR;
    PG8_WAIT_V(2); PG8_BAR;
    PG8_STAGE(PG8_SB(1, 0), rsB, cB + kstep, voffB0, voffB1); PG8_STAGE(PG8_SA(1, 0), rsA, cA + kstep, vA[0][0], vA[0][1]); PG8_STAGE(PG8_SB(1, 1), rsB, cB + hstep + kstep, voffB0, voffB1);
    PG8_WAIT_V(6); PG8_BAR;
    for (;;) {
        const bool has_next = S.next(ui + 1, nxt);
        unsigned nA = cA, nB = cB;
        if (has_next) S.addr(nxt, nA, nB);
        if constexpr (GATHER) {
            if (has_next) { const int* gi = S.gidx(nxt);
#pragma unroll
                for (int h = 0; h < 2; ++h)
#pragma unroll
                    for (int i = 0; i < 2; ++i) nvA[h][i] = (unsigned)(gi[h * HALF + Rs[i]] * RB + Cs[i] * 2);
            } else {
#pragma unroll
                for (int h = 0; h < 2; ++h)
#pragma unroll
                    for (int i = 0; i < 2; ++i) nvA[h][i] = vA[h][i];
            }
        }
#pragma unroll (FP8 ? 1 : 2)
        for (int t = 0; t < nt; t += 2) {
            const bool last = (t == nt - 2);
            const unsigned a1 = cA + (unsigned)(t + 1) * kstep;
            const unsigned a2 = last ? nA : cA + (unsigned)(t + 2) * kstep, b2 = last ? nB : cB + (unsigned)(t + 2) * kstep;
            const unsigned a3 = a2 + kstep, b3 = b2 + kstep;
            if constexpr (MIDHOOK) { if (t == nt / 2) E.mid(acc, cur, wr, wc, fr, fq); }
            PG8_LDB(B0, 0, 0); PG8_LDB(B1, 0, 1); PG8_SCHED; PG8_LDA(At, 0, 0); PG8_STAGE(PG8_SA(1, 1), rsA, a1 + (GATHER ? 0u : hstep), vA[GATHER ? 1 : 0][0], vA[GATHER ? 1 : 0][1]);
            PG8_WAIT_V(8); PG8_WAIT_L(0); PG8_BAR; PG8_MMA(0, 0, At, B0); PG8_MMA(0, 1, At, B1); PG8_BAR; PG8_SCHED;
            if constexpr (GATHER) { if (last) {
#pragma unroll
                for (int h = 0; h < 2; ++h)
#pragma unroll
                    for (int i = 0; i < 2; ++i) vA[h][i] = nvA[h][i]; } }
            PG8_LDA(At, 0, 1); PG8_STAGE(PG8_SB(0, 0), rsB, b2, voffB0, voffB1); PG8_STAGE(PG8_SB(0, 1), rsB, b2 + hstep, voffB0, voffB1); PG8_STAGE(PG8_SA(0, 0), rsA, a2, vA[0][0], vA[0][1]);
            PG8_WAIT_V(8); PG8_WAIT_L(0); PG8_BAR; PG8_MMA(1, 0, At, B0); PG8_MMA(1, 1, At, B1); PG8_BAR; PG8_SCHED;
            PG8_LDB(B0, 1, 0); PG8_LDB(B1, 1, 1); PG8_SCHED; PG8_LDA(At, 1, 0); PG8_STAGE(PG8_SA(0, 1), rsA, a2 + (GATHER ? 0u : hstep), vA[GATHER ? 1 : 0][0], vA[GATHER ? 1 : 0][1]);
            PG8_WAIT_V(8); PG8_WAIT_L(0); PG8_BAR; PG8_MMA(0, 0, At, B0); PG8_MMA(0, 1, At, B1); PG8_BAR; PG8_SCHED;
            PG8_LDA(At, 1, 1); PG8_STAGE(PG8_SB(1, 0), rsB, b3, voffB0, voffB1); PG8_STAGE(PG8_SB(1, 1), rsB, b3 + hstep, voffB0, voffB1); PG8_STAGE(PG8_SA(1, 0), rsA, a3, vA[0][0], vA[0][1]);
            PG8_WAIT_V(8); PG8_WAIT_L(0); PG8_BAR; PG8_MMA(1, 0, At, B0); PG8_MMA(1, 1, At, B1); PG8_BAR; PG8_SCHED;
        }
        if constexpr (ALIGN_EPI) { if (wr == 0) PG8_BAR; }
        E(acc, cur, wr, wc, fr, fq);
        if (!has_next) break;
#pragma unroll
        for (int a = 0; a < 2; ++a)
#pragma unroll
            for (int b = 0; b < 2; ++b)
#pragma unroll
                for (int m = 0; m < 4; ++m)
#pragma unroll
                    for (int n = 0; n < 2; ++n) acc[a][b][m][n] = (f32x4){0.f, 0.f, 0.f, 0.f};
        cur = nxt; cA = nA; cB = nB; ++ui;
        if constexpr (GATHER) {
#pragma unroll
            for (int h = 0; h < 2; ++h)
#pragma unroll
                for (int i = 0; i < 2; ++i) vA[h][i] = nvA[h][i];
        }
        if constexpr (ALIGN_EPI) { if (wr == 1) PG8_BAR; }
    }
    PG8_WAIT_V(0);
    if constexpr (!ALIGN_EPI) { if (wr == 0) PG8_BAR; }
    PG8_BAR;
}

template <class Epi, class Sched, bool GATHER, bool MIDHOOK>
__device__ __forceinline__ void gemm_phase_naive(const int K, const Sched& S, const Epi& E) {
    const int tid = tid_l(), wid = tid >> 6, lane = tid & 63, wr = wid >> 2, wc = wid & 3, fr = lane & 15, fq = lane >> 4;
    Unit u;
    for (int i = 0; S.next(i, u); ++i) {
        unsigned ao_, bo_; S.addr(u, ao_, bo_); const char* A = S.A + ao_; const char* B = S.B + bo_; const int* gi = S.gidx(u);
        f32x4 acc[2][2][4][2];
#pragma unroll
        for (int a = 0; a < 2; ++a)
#pragma unroll
            for (int b = 0; b < 2; ++b)
#pragma unroll
                for (int m = 0; m < 4; ++m)
#pragma unroll
                    for (int n = 0; n < 2; ++n) acc[a][b][m][n] = (f32x4){0.f, 0.f, 0.f, 0.f};
        for (int half = 0; half < (MIDHOOK ? 2 : 1); ++half) {
            const int k_lo = MIDHOOK ? half * (K / 2) : 0, k_hi = MIDHOOK ? (half + 1) * (K / 2) : K;
            if (MIDHOOK && half == 1) E.mid(acc, u, wr, wc, fr, fq);
#pragma unroll
            for (int ai = 0; ai < 2; ++ai)
#pragma unroll
                for (int m = 0; m < 4; ++m) {
                    const int rloc = 128 * ai + 64 * wr + 16 * m + fr;
                    const int arow = GATHER ? gi[rloc] : rloc;
                    const bf16_t* ap = (const bf16_t*)A + (size_t)arow * K;
#pragma unroll
                    for (int bj = 0; bj < 2; ++bj)
#pragma unroll
                        for (int n = 0; n < 2; ++n)
#pragma unroll
                            for (int j = 0; j < 4; ++j) {
                                const int cloc = 128 * bj + 32 * wc + (Epi::PERM ? 8 * fq + 4 * n + j : 16 * n + 4 * fq + j);
                                const bf16_t* bp = (const bf16_t*)B + (size_t)cloc * K;
                                float s = 0.f;
                                for (int k = k_lo; k < k_hi; k += 8) {
                                    const u32x4 av = *(const u32x4*)(ap + k), bv = *(const u32x4*)(bp + k);
                                    s += bflo(av.x) * bflo(bv.x) + bfhi(av.x) * bfhi(bv.x) + bflo(av.y) * bflo(bv.y) + bfhi(av.y) * bfhi(bv.y)
                                       + bflo(av.z) * bflo(bv.z) + bfhi(av.z) * bfhi(bv.z) + bflo(av.w) * bflo(bv.w) + bfhi(av.w) * bfhi(bv.w);
                                }
                                acc[ai][bj][m][n][j] += s;
                            }
                }
        }
        E(acc, u, wr, wc, fr, fq);
    }
}

struct EpiProj {
    static constexpr bool PERM = true;
    bf16_t* qkvus; bf16_t* gates; const float* b_gate; float* kn2;
    __device__ __forceinline__ void operator()(const f32x4 (&acc)[2][2][4][2], const Unit& u, int wr, int wc, int fr, int fq) const {
        const int pn = u.pn, row0 = u.orow + wr * 64 + fr;
        bf16_t* base; int ldc, mode, colt;
        if (pn < 10) { const int which = pn >> 1; base = qkvus + (size_t)which * ((size_t)MTOK * 512); ldc = 512; colt = (pn & 1) * 256; mode = which == 0 ? 0 : (which < 3 ? 1 : 2); }
        else { base = gates; ldc = 2048; colt = (pn - 10) * 256; mode = 3; }
        const int col0 = colt + wc * 32 + 8 * fq;
        f32x4 bv[2][2];
#pragma unroll
        for (int bj = 0; bj < 2; ++bj)
#pragma unroll
            for (int n = 0; n < 2; ++n) bv[bj][n] = (mode == 3) ? *(const f32x4*)(b_gate + col0 + bj * HALF + 4 * n) : (f32x4){0.f, 0.f, 0.f, 0.f};
#pragma unroll
        for (int ai = 0; ai < 2; ++ai)
#pragma unroll
            for (int m = 0; m < 4; ++m) { bf16_t* rowp = base + (size_t)(row0 + ai * HALF + m * 16) * ldc + col0;
#pragma unroll
                for (int bj = 0; bj < 2; ++bj) { f32x4 v0 = acc[ai][bj][m][0] + bv[bj][0], v1 = acc[ai][bj][m][1] + bv[bj][1];
                    if (mode == 0) { v0 = v0 * C2; v1 = v1 * C2; }
                    else if (mode == 2) gelu8(v0, v1);
                    else if (mode == 3) {
#pragma unroll
                        for (int j = 0; j < 4; ++j) { v0[j] = sigmoidf_(v0[j]); v1[j] = sigmoidf_(v1[j]); } }
                    u32x4 w; w.x = cvt_pk_bf16(v0[0], v0[1]); w.y = cvt_pk_bf16(v0[2], v0[3]); w.z = cvt_pk_bf16(v1[0], v1[1]); w.w = cvt_pk_bf16(v1[2], v1[3]);
                    *(u32x4*)(rowp + bj * HALF) = w;
                    if (pn == 2 || pn == 3) {
                        float ssq = bflo(w.x) * bflo(w.x); ssq = fmaf(bfhi(w.x), bfhi(w.x), ssq); ssq = fmaf(bflo(w.y), bflo(w.y), ssq); ssq = fmaf(bfhi(w.y), bfhi(w.y), ssq);
                        ssq = fmaf(bflo(w.z), bflo(w.z), ssq); ssq = fmaf(bfhi(w.z), bfhi(w.z), ssq); ssq = fmaf(bflo(w.w), bflo(w.w), ssq); ssq = fmaf(bfhi(w.w), bfhi(w.w), ssq);
                        ssq += swz_xor<16>(ssq);
                        { auto rr = __builtin_amdgcn_permlane32_swap(__float_as_uint(ssq), __float_as_uint(ssq), false, false); ssq = __uint_as_float(rr[0]) + __uint_as_float(rr[1]); }
                        if (fq == 0) atomicAdd(kn2 + (size_t)(row0 + ai * HALF + m * 16) * 8 + (pn - 2) * 4 + 2 * bj + (wc >> 1), ssq); }
                } }
    }
};
struct EpiGate {
    static constexpr bool PERM = true;
    bf16_t* gates; const float* b_gate;
    __device__ __forceinline__ void operator()(const f32x4 (&acc)[2][2][4][2], const Unit& u, int wr, int wc, int fr, int fq) const {
        const int row0 = u.orow + wr * 64 + fr, col0 = u.pn * BM + wc * 32 + 8 * fq; constexpr float SI = 1.f / (MOE_WSCALE * MOE_HSCALE);
        f32x4 bv[2][2];
#pragma unroll
        for (int bj = 0; bj < 2; ++bj)
#pragma unroll
            for (int n = 0; n < 2; ++n) bv[bj][n] = *(const f32x4*)(b_gate + col0 + bj * HALF + 4 * n) * (-LOG2E);
#pragma unroll
        for (int ai = 0; ai < 2; ++ai)
#pragma unroll
            for (int m = 0; m < 4; ++m) { bf16_t* rowp = gates + (size_t)(row0 + ai * HALF + m * 16) * 2048 + col0;
#pragma unroll
                for (int bj = 0; bj < 2; ++bj) { f32x4 v0, v1;
#pragma unroll
                    for (int j = 0; j < 4; ++j) { v0[j] = __builtin_amdgcn_rcpf(1.f + __builtin_amdgcn_exp2f(fmaf(acc[ai][bj][m][0][j], -LOG2E * SI, bv[bj][0][j])));
                                                  v1[j] = __builtin_amdgcn_rcpf(1.f + __builtin_amdgcn_exp2f(fmaf(acc[ai][bj][m][1][j], -LOG2E * SI, bv[bj][1][j]))); }
                    u32x4 w; w.x = cvt_pk_bf16(v0[0], v0[1]); w.y = cvt_pk_bf16(v0[2], v0[3]); w.z = cvt_pk_bf16(v1[0], v1[1]); w.w = cvt_pk_bf16(v1[2], v1[3]);
                    *(u32x4*)(rowp + bj * HALF) = w; } }
    }
};
struct EpiMix {
    static constexpr bool PERM = true;
    const bf16_t* gates; bf16_t* mixed;
    __device__ __forceinline__ void mid(f32x4 (&acc)[2][2][4][2], const Unit& u, int, int, int, int) const {
        int t_ = threadIdx.x; asm volatile("" : "+v"(t_));
        const int wid_ = t_ >> 6, wr = wid_ >> 2, wc = wid_ & 3, fr = t_ & 15, fq = (t_ & 63) >> 4;
        const int row0 = u.orow + wr * 64 + fr, col0 = u.pn * BM + wc * 32 + 8 * fq;
#pragma unroll
        for (int ai = 0; ai < 2; ++ai)
#pragma unroll
            for (int m = 0; m < 4; ++m) { const bf16_t* gp = gates + (size_t)(row0 + ai * HALF + m * 16) * 2048 + col0; asm volatile("" : "+v"(gp));
#pragma unroll
                for (int bj = 0; bj < 2; ++bj) { const u32x4 ga = *(const u32x4*)(gp + bj * HALF), gb = *(const u32x4*)(gp + 1024 + bj * HALF);
                    f32x4 r0, r1;
                    r0[0] = bflo(ga.x) * __builtin_amdgcn_rcpf(bflo(gb.x)); r0[1] = bfhi(ga.x) * __builtin_amdgcn_rcpf(bfhi(gb.x)); r0[2] = bflo(ga.y) * __builtin_amdgcn_rcpf(bflo(gb.y)); r0[3] = bfhi(ga.y) * __builtin_amdgcn_rcpf(bfhi(gb.y));
                    r1[0] = bflo(ga.z) * __builtin_amdgcn_rcpf(bflo(gb.z)); r1[1] = bfhi(ga.z) * __builtin_amdgcn_rcpf(bfhi(gb.z)); r1[2] = bflo(ga.w) * __builtin_amdgcn_rcpf(bflo(gb.w)); r1[3] = bfhi(ga.w) * __builtin_amdgcn_rcpf(bfhi(gb.w));
                    acc[ai][bj][m][0] = acc[ai][bj][m][0] * r0; acc[ai][bj][m][1] = acc[ai][bj][m][1] * r1; } }
    }
    __device__ __forceinline__ void operator()(const f32x4 (&acc)[2][2][4][2], const Unit& u, int wr, int wc, int fr, int fq) const {
        const int row0 = u.orow + wr * 64 + fr, col0 = u.pn * BM + wc * 32 + 8 * fq;
#pragma unroll
        for (int ai = 0; ai < 2; ++ai)
#pragma unroll
            for (int m = 0; m < 4; ++m) { const size_t r = (size_t)(row0 + ai * HALF + m * 16);
#pragma unroll
                for (int bj = 0; bj < 2; ++bj) { const u32x4 gb = *(const u32x4*)(gates + r * 2048 + 1024 + col0 + bj * HALF);
                    const f32x4 v0 = acc[ai][bj][m][0], v1 = acc[ai][bj][m][1];
                    u32x4 w; w.x = cvt_pk_bf16(v0[0] * bflo(gb.x), v0[1] * bfhi(gb.x)); w.y = cvt_pk_bf16(v0[2] * bflo(gb.y), v0[3] * bfhi(gb.y));
                    w.z = cvt_pk_bf16(v1[0] * bflo(gb.z), v1[1] * bfhi(gb.z)); w.w = cvt_pk_bf16(v1[2] * bflo(gb.w), v1[3] * bfhi(gb.w));
                    *(u32x4*)(mixed + r * 1024 + col0 + bj * HALF) = w; } }
    }
};
struct EpiRes {
    static constexpr bool PERM = true;
    const float* x; bf16_t* out;
    __device__ __forceinline__ void operator()(const f32x4 (&acc)[2][2][4][2], const Unit& u, int wr, int wc, int fr, int fq) const {
        const int row0 = u.orow + wr * 64 + fr, col0 = u.pn * BM + wc * 32 + 8 * fq;
#pragma unroll
        for (int ai = 0; ai < 2; ++ai)
#pragma unroll
            for (int m = 0; m < 4; ++m) { const size_t off = (size_t)(row0 + ai * HALF + m * 16) * DM + col0;
#pragma unroll
                for (int bj = 0; bj < 2; ++bj) { const f32x4 b0 = *(const f32x4*)(x + off + bj * HALF), b1 = *(const f32x4*)(x + off + bj * HALF + 4);
                    const f32x4 v0 = b0 + acc[ai][bj][m][0], v1 = b1 + acc[ai][bj][m][1];
                    u32x4 w; w.x = cvt_pk_bf16(v0[0], v0[1]); w.y = cvt_pk_bf16(v0[2], v0[3]); w.z = cvt_pk_bf16(v1[0], v1[1]); w.w = cvt_pk_bf16(v1[2], v1[3]);
                    *(u32x4*)(out + off + bj * HALF) = w; } }
    }
};
struct EpiSwiglu {
    static constexpr bool PERM = true;
    unsigned char* act;
    __device__ __forceinline__ void operator()(const f32x4 (&acc)[2][2][4][2], const Unit& u, int, int, int, int) const {
        const int t_ = tid_l(), wid_ = t_ >> 6, wr = wid_ >> 2, wc = wid_ & 3, fr = t_ & 15, fq = (t_ & 63) >> 4;
        const int row0 = u.orow + wr * 64 + fr, col0 = u.pn * HALF + wc * 32 + 8 * fq;
#pragma unroll
        for (int ai = 0; ai < 2; ++ai)
#pragma unroll
            for (int m = 0; m < 4; ++m) {
                f32x4 o0, o1; constexpr float SI = 1.f / (MOE_WSCALE * MOE_HSCALE), IKK = 1.f / (SI * SI * MOE_ASCALE), CE = -LOG2E * SI;
#pragma unroll
                for (int j = 0; j < 4; ++j) {
                    const float g0 = acc[ai][0][m][0][j], g1 = acc[ai][0][m][1][j];
                    const float e0 = __builtin_amdgcn_exp2f(g0 * CE), e1 = __builtin_amdgcn_exp2f(g1 * CE);
                    o0[j] = (g0 * acc[ai][1][m][0][j]) * __builtin_amdgcn_rcpf(fmaf(e0, IKK, IKK));
                    o1[j] = (g1 * acc[ai][1][m][1][j]) * __builtin_amdgcn_rcpf(fmaf(e1, IKK, IKK)); }
                int w0 = 0, w1 = 0;
                w0 = __builtin_amdgcn_cvt_pk_fp8_f32(o0[0], o0[1], w0, false); w0 = __builtin_amdgcn_cvt_pk_fp8_f32(o0[2], o0[3], w0, true);
                w1 = __builtin_amdgcn_cvt_pk_fp8_f32(o1[0], o1[1], w1, false); w1 = __builtin_amdgcn_cvt_pk_fp8_f32(o1[2], o1[3], w1, true);
                u32x2 w; w.x = (unsigned)w0; w.y = (unsigned)w1;
                *(u32x2*)(act + (size_t)(row0 + ai * HALF + m * 16) * FF + col0) = w; }
    }
};
struct EpiDown {
    static constexpr bool PERM = true;
    const float* gv; unsigned char* y;
    __device__ __forceinline__ void operator()(const f32x4 (&acc)[2][2][4][2], const Unit& u, int, int, int, int) const {
        const int t_ = tid_l(), wid_ = t_ >> 6, wr = wid_ >> 2, wc = wid_ & 3, fr = t_ & 15, fq = (t_ & 63) >> 4;
        const int row0 = u.orow + wr * 64 + fr, col0 = u.pn * BM + wc * 32 + 8 * fq;
#pragma unroll
        for (int ai = 0; ai < 2; ++ai)
#pragma unroll
            for (int m = 0; m < 4; ++m) { const int r = row0 + ai * HALF + m * 16; const float g = gv[r] * (MOE_YSCALE / (MOE_WSCALE * MOE_ASCALE));
#pragma unroll
                for (int bj = 0; bj < 2; ++bj) { const f32x4 v0 = acc[ai][bj][m][0] * g, v1 = acc[ai][bj][m][1] * g;
                    int w0 = 0, w1 = 0;
                    w0 = __builtin_amdgcn_cvt_pk_fp8_f32(v0[0], v0[1], w0, false); w0 = __builtin_amdgcn_cvt_pk_fp8_f32(v0[2], v0[3], w0, true);
                    w1 = __builtin_amdgcn_cvt_pk_fp8_f32(v1[0], v1[1], w1, false); w1 = __builtin_amdgcn_cvt_pk_fp8_f32(v1[2], v1[3], w1, true);
                    u32x2 w; w.x = (unsigned)w0; w.y = (unsigned)w1;
                    *(u32x2*)(y + (size_t)r * DM + col0 + bj * HALF) = w; } }
    }
};
}

struct Args { const float* in[22]; float* out; unsigned char* ws; int ph_lo, ph_hi; };
struct Frame {
    LAS unsigned char* lds; unsigned char* ldsg;
    int tid, lane, wave, vcu, G;
    const float* in[22]; float* out; unsigned char* ws;
};

__device__ __forceinline__ unsigned pk2(float lo, float hi) { return cvt_pk_bf16(lo, hi); }
__device__ __forceinline__ void p0_transpose_item(const float* __restrict__ W, int K, int N, bf16_t* WT, int dst_row, int k0, int n0, LAS float* scr, int lane) {
#pragma unroll 8
    for (int i = 0; i < 32; ++i) { const int kk = 2 * i + (lane >> 5); scr[kk * 33 + (lane & 31)] = W[(size_t)(k0 + kk) * N + n0 + (lane & 31)]; }
    LDS_WAIT(); asm volatile("" ::: "memory");
    const int c = lane & 7;
#pragma unroll
    for (int j = 0; j < 4; ++j) { const int n = (lane >> 3) + 8 * j; const LAS float* s = scr + (8 * c) * 33 + n;
        u32x4 o; o.x = pk2(s[0 * 33], s[1 * 33]); o.y = pk2(s[2 * 33], s[3 * 33]); o.z = pk2(s[4 * 33], s[5 * 33]); o.w = pk2(s[6 * 33], s[7 * 33]);
        *(u32x4*)(WT + (size_t)(dst_row + n) * K + k0 + 8 * c) = o; }
    LDS_WAIT(); asm volatile("" ::: "memory");
}
__device__ __forceinline__ void p0_transpose_item_fp8(const float* __restrict__ W, int K, int N, unsigned char* WT, int dst_row, int k0, int n0, LAS float* scr, int lane) {
#pragma unroll 8
    for (int i = 0; i < 32; ++i) { const int kk = 2 * i + (lane >> 5); scr[kk * 33 + (lane & 31)] = W[(size_t)(k0 + kk) * N + n0 + (lane & 31)]; }
    LDS_WAIT(); asm volatile("" ::: "memory");
    const int c = lane & 7;
#pragma unroll
    for (int j = 0; j < 4; ++j) { const int n = (lane >> 3) + 8 * j; const LAS float* s = scr + (8 * c) * 33 + n;
        int w0 = 0, w1 = 0;
        w0 = __builtin_amdgcn_cvt_pk_fp8_f32(s[0 * 33] * MOE_WSCALE, s[1 * 33] * MOE_WSCALE, w0, false); w0 = __builtin_amdgcn_cvt_pk_fp8_f32(s[2 * 33] * MOE_WSCALE, s[3 * 33] * MOE_WSCALE, w0, true);
        w1 = __builtin_amdgcn_cvt_pk_fp8_f32(s[4 * 33] * MOE_WSCALE, s[5 * 33] * MOE_WSCALE, w1, false); w1 = __builtin_amdgcn_cvt_pk_fp8_f32(s[6 * 33] * MOE_WSCALE, s[7 * 33] * MOE_WSCALE, w1, true);
        u32x2 o; o.x = (unsigned)w0; o.y = (unsigned)w1;
        *(u32x2*)(WT + (size_t)(dst_row + n) * K + k0 + 8 * c) = o; }
    LDS_WAIT(); asm volatile("" ::: "memory");
}
constexpr int EXP_ITEMS = 3 * 16384;
#ifndef EXP_P2_ITEMS
#define EXP_P2_ITEMS 24576
#endif
#ifndef EXP_P6_ITEMS
#define EXP_P6_ITEMS 8192
#endif
__device__ __forceinline__ void expert_item(Frame& F, int r, LAS float* scr) {
    unsigned char* Wgu = (unsigned char*)(F.ws + WS_WGU); unsigned char* Wd = (unsigned char*)(F.ws + WS_WD);
    const int seg = r / 16384, q = r % 16384, e = q / 1024, t = q % 1024;
    if (seg < 2) { const int kb = t / 64, nb = t % 64, n0 = 32 * nb;
        p0_transpose_item_fp8((seg == 0 ? F.in[18] : F.in[19]) + (size_t)e * 1024 * 2048, 1024, 2048, Wgu + (size_t)e * 4096 * 1024, (n0 >> 7) * 256 + (n0 & 127) + seg * 128, 64 * kb, n0, scr, F.lane); }
    else { const int kb = t / 32, nb = t % 32;
        p0_transpose_item_fp8(F.in[20] + (size_t)e * 2048 * 1024, 2048, 1024, Wd + (size_t)e * 1024 * 2048, 32 * nb, 64 * kb, 32 * nb, scr, F.lane); }
}
__device__ __forceinline__ void p0_prologue(Frame& F) {
    LAS float* scr = (LAS float*)(F.lds + F.wave * 16384);
    const int gw = F.vcu * NWAVES + F.wave, NGW = F.G * NWAVES;
    bf16_t* Wcat = (bf16_t*)(F.ws + WS_WCAT); bf16_t* Wbr = (bf16_t*)(F.ws + WS_WBR); bf16_t* Wout = (bf16_t*)(F.ws + WS_WOUT);
    constexpr int I0 = 16 * 80, I1 = I0 + 16 * 64, I2 = I1 + 16 * 32, I3 = I2 + 16 * 32, NITEMS = I3 + EXP_ITEMS - (EXP_P2_ITEMS + EXP_P6_ITEMS);
    for (int it = gw; it < NITEMS; it += NGW) {
        if (it < I0) { const int kb = it / 80, nb = it % 80; p0_transpose_item(F.in[2], 1024, 2560, Wcat, 32 * nb, 64 * kb, 32 * nb, scr, F.lane); }
        else if (it < I1) { const int r = it - I0, kb = r / 64, nb = r % 64; p0_transpose_item_fp8(F.in[3], 1024, 2048, (unsigned char*)(F.ws + WS_WG8), 32 * nb, 64 * kb, 32 * nb, scr, F.lane); }
        else if (it < I2) { const int r = it - I1, kb = r / 32, nb = r % 32; p0_transpose_item(F.in[14], 1024, 1024, Wbr, 32 * nb, 64 * kb, 32 * nb, scr, F.lane); }
        else if (it < I3) { const int r = it - I2, kb = r / 32, nb = r % 32; p0_transpose_item(F.in[15], 1024, 1024, Wout, 32 * nb, 64 * kb, 32 * nb, scr, F.lane); }
        else expert_item(F, it - I3 + (EXP_P2_ITEMS + EXP_P6_ITEMS), scr);
    }
    { f32x4* z = (f32x4*)(F.ws + WS_KN2); const int gt = F.vcu * NTHREADS + F.tid; for (int i = gt; i < MTOK * 8 / 4; i += F.G * NTHREADS) z[i] = (f32x4){0.f, 0.f, 0.f, 0.f}; }
    { bf16_t* Ws = (bf16_t*)(F.ws + WS_WSGU); const int gt = F.vcu * NTHREADS + F.tid;
      for (int i = gt; i < 65536 / 8; i += F.G * NTHREADS) { const f32x4 a = *(const f32x4*)(F.in[12] + i * 8), b = *(const f32x4*)(F.in[12] + i * 8 + 4);
          u32x4 o; o.x = pk2(a[0], a[1]); o.y = pk2(a[2], a[3]); o.z = pk2(b[0], b[1]); o.w = pk2(b[2], b[3]); *(u32x4*)(Ws + i * 8) = o; } }
    bf16_t* XN = (bf16_t*)((unsigned char*)F.out + DO_XN);
    const float* g = F.in[1];
    f32x4 gg[4];
#pragma unroll
    for (int j = 0; j < 4; ++j) gg[j] = *(const f32x4*)(g + (F.lane + 64 * j) * 4);
    for (int m = gw; m < MTOK; m += NGW) {
        const f32x4* xr = (const f32x4*)(F.in[0] + (size_t)m * DM) + F.lane;
        f32x4 v[4]; float s = 0.f;
#pragma unroll
        for (int j = 0; j < 4; ++j) { v[j] = xr[64 * j]; s += (v[j].x * v[j].x + v[j].y * v[j].y) + (v[j].z * v[j].z + v[j].w * v[j].w); }
        const float r = rsqrtf(wave_sum(s) * (1.f / DM) + EPS);
        u32x2* o8 = (u32x2*)(XN + (size_t)m * DM) + F.lane; int* o4 = (int*)((unsigned char*)F.out + DO_XN8 + (size_t)m * DM) + F.lane;
#pragma unroll
        for (int j = 0; j < 4; ++j) { const f32x4 h = {v[j].x * r * gg[j].x, v[j].y * r * gg[j].y, v[j].z * r * gg[j].z, v[j].w * r * gg[j].w};
            u32x2 w; w.x = pk2(h.x, h.y); w.y = pk2(h.z, h.w); o8[64 * j] = w;
            int p8 = 0; p8 = __builtin_amdgcn_cvt_pk_fp8_f32(h.x * MOE_HSCALE, h.y * MOE_HSCALE, p8, false); p8 = __builtin_amdgcn_cvt_pk_fp8_f32(h.z * MOE_HSCALE, h.w * MOE_HSCALE, p8, true); o4[64 * j] = p8; }
    }
}

namespace att {
constexpr int KVBLK = 64, QBLK = 32, NT = SEQ / KVBLK;
constexpr int SHM_V = 64 * 128 * 2, SHM_K = 64 * 64 * 2;
constexpr int NSLOT = 3, OFF_K = 0, OFF_V = NSLOT * SHM_K, OFF_WS = NSLOT * (SHM_K + SHM_V), OFF_NRM = OFF_WS + 2048, OFF_OST = OFF_NRM + 2048;
static_assert(OFF_OST + 8 * 8192 <= LDSCTL_OFF, "attention LDS map");
constexpr int OFF_OST_COMMENT = 0;
constexpr float THR2 = 32.f;
#define KSWZ64(row, colB) ((row) * 128 + ((colB) ^ ((((row) >> 1) & 7) << 4)))
__device__ __forceinline__ int crow(int r, int hi) { return (r & 3) + 8 * (r >> 2) + 4 * hi; }
__device__ __forceinline__ int v_st(int k, int c) { const int kk = (k & ~0xC) | ((k & 4) << 1) | ((k & 8) >> 1); return ((kk >> 3) * 4 + (c >> 5)) * 512 + ((kk & 7) * 32 + (c & 31)) * 2; }
__device__ __forceinline__ int v_rd_base(int lane) { return ((lane & 3) << 3) | (((lane >> 2) & 3) << 6) | (((lane >> 4) & 1) << 5) | (((lane >> 5) & 1) << 8); }
constexpr int v_rd_off(int d0, int ks, int half) { return d0 * 512 + ks * 4096 + half * 2048; }
template <int OFF> __device__ __forceinline__ s16x4 tr_read(int vb) {
    s16x4 r; asm volatile("ds_read_b64_tr_b16 %0, %1 offset:%2" : "=&v"(r) : "v"(vb), "i"(OFF) : "memory"); return r;
}
template <int D0> __device__ __forceinline__ void pv_one(f32x16& od, int vb, bf16x8 pa0, bf16x8 pa1, bf16x8 pa2, bf16x8 pa3) {
    const s16x4 l0 = tr_read<v_rd_off(D0, 0, 0)>(vb), h0 = tr_read<v_rd_off(D0, 0, 1)>(vb), l1 = tr_read<v_rd_off(D0, 1, 0)>(vb), h1 = tr_read<v_rd_off(D0, 1, 1)>(vb);
    const s16x4 l2 = tr_read<v_rd_off(D0, 2, 0)>(vb), h2 = tr_read<v_rd_off(D0, 2, 1)>(vb), l3 = tr_read<v_rd_off(D0, 3, 0)>(vb), h3 = tr_read<v_rd_off(D0, 3, 1)>(vb);
    asm volatile("s_waitcnt lgkmcnt(0)" ::: "memory"); SBAR();
#define PK(L, H) (bf16x8){L[0], L[1], L[2], L[3], H[0], H[1], H[2], H[3]}
    __builtin_amdgcn_s_setprio(1);
    od = __builtin_amdgcn_mfma_f32_32x32x16_bf16(pa0, PK(l0, h0), od, 0, 0, 0);
    od = __builtin_amdgcn_mfma_f32_32x32x16_bf16(pa1, PK(l1, h1), od, 0, 0, 0);
    od = __builtin_amdgcn_mfma_f32_32x32x16_bf16(pa2, PK(l2, h2), od, 0, 0, 0);
    od = __builtin_amdgcn_mfma_f32_32x32x16_bf16(pa3, PK(l3, h3), od, 0, 0, 0);
    __builtin_amdgcn_s_setprio(0);
#undef PK
}
__device__ __forceinline__ void pv_d0(f32x16* o, int vb, bf16x8 pa0, bf16x8 pa1, bf16x8 pa2, bf16x8 pa3) {
    pv_one<0>(o[0], vb, pa0, pa1, pa2, pa3); pv_one<1>(o[1], vb, pa0, pa1, pa2, pa3); pv_one<2>(o[2], vb, pa0, pa1, pa2, pa3); pv_one<3>(o[3], vb, pa0, pa1, pa2, pa3);
}
__device__ __forceinline__ float max3f(float a, float b, float c) { float r; asm("v_max3_f32 %0, %1, %2, %3" : "=v"(r) : "v"(a), "v"(b), "v"(c)); return r; }
__device__ __forceinline__ void partialSM(f32x16& p0, f32x16& p1, float& m_reg, float& mn, float& alpha, float dq, float nsl2, int side) {
    asm volatile("" : "+v"(dq));
    float A;
    if (side == 0) {
        A = 0.f;
#pragma unroll
        for (int r = 0; r < 16; ++r) { const float c = (float)((r & 3) + 8 * (r >> 2)); p0[r] = fmaf(nsl2, fabsf(dq - c), p0[r]); p1[r] = fmaf(nsl2, fabsf(dq - (c + 32.f)), p1[r]); }
    } else {
        const float coef = side < 0 ? -nsl2 : nsl2;
        A = side < 0 ? nsl2 * dq : -nsl2 * dq;
#pragma unroll
        for (int r = 0; r < 16; ++r) { const float c = (float)((r & 3) + 8 * (r >> 2)); p0[r] = fmaf(coef, c, p0[r]); p1[r] = fmaf(coef, c + 32.f, p1[r]); }
    }
    float pa = max3f(p0[0], p0[1], p1[0]), pb = max3f(p0[2], p0[3], p1[1]); pa = max3f(pa, p1[2], p1[3]);
#pragma unroll
    for (int r = 4; r < 16; r += 4) { pa = max3f(pa, p0[r], p0[r + 1]); pb = max3f(pb, p0[r + 2], p0[r + 3]); pa = max3f(pa, p1[r], p1[r + 1]); pb = max3f(pb, p1[r + 2], p1[r + 3]); }
    float pmax = fmaxf(pa, pb) + A;
    { auto rr = __builtin_amdgcn_permlane32_swap(__float_as_uint(pmax), __float_as_uint(pmax), false, false);
      pmax = fmaxf(__uint_as_float(rr[0]), __uint_as_float(rr[1])); }
    if (__builtin_expect(__all(pmax - m_reg <= THR2), 1)) { mn = m_reg; alpha = 1.f; }
    else { mn = fmaxf(m_reg, pmax); alpha = __builtin_amdgcn_exp2f(m_reg - mn); m_reg = mn; }
    const float sub = mn - A;
#pragma unroll
    for (int r = 0; r < 16; ++r) { p0[r] -= sub; p1[r] -= sub; }
#pragma unroll
    for (int r = 0; r < 16; ++r) p0[r] = __builtin_amdgcn_exp2f(p0[r]);
}
__device__ __forceinline__ void finishSM(f32x16& p0, f32x16& p1, float alpha, float& l_reg, bf16x8& pa0, bf16x8& pa1, bf16x8& pa2, bf16x8& pa3) {
#pragma unroll
    for (int r = 0; r < 16; ++r) p1[r] = __builtin_amdgcn_exp2f(p1[r]);
    float ps = 0;
#pragma unroll
    for (int r = 0; r < 16; ++r) ps += p0[r];
#pragma unroll
    for (int r = 0; r < 16; ++r) ps += p1[r];
    { auto rr = __builtin_amdgcn_permlane32_swap(__float_as_uint(ps), __float_as_uint(ps), false, false);
      ps = __uint_as_float(rr[0]) + __uint_as_float(rr[1]); }
    l_reg = l_reg * alpha + ps;
#define PK4(P, BASE, OUT) do { unsigned a0 = cvt_pk_bf16(P[BASE + 0], P[BASE + 1]), a1 = cvt_pk_bf16(P[BASE + 2], P[BASE + 3]);   \
    unsigned b0 = cvt_pk_bf16(P[BASE + 4], P[BASE + 5]), b1 = cvt_pk_bf16(P[BASE + 6], P[BASE + 7]);                              \
    auto r0 = __builtin_amdgcn_permlane32_swap(a0, b0, false, false); auto r1 = __builtin_amdgcn_permlane32_swap(a1, b1, false, false); \
    u32x4 w = {r0[0], r1[0], r0[1], r1[1]}; OUT = *reinterpret_cast<bf16x8*>(&w); } while (0)
    PK4(p0, 0, pa0); PK4(p0, 8, pa1); PK4(p1, 0, pa2); PK4(p1, 8, pa3);
#undef PK4
}
__device__ __forceinline__ unsigned bf16_bits(float x) { return cvt_pk_bf16(x, 0.f) & 0xffffu; }
__device__ __forceinline__ unsigned pack2(float lo, float hi) { return cvt_pk_bf16(lo, hi); }
__device__ __forceinline__ void qkt_f(f32x16& p0, f32x16& p1, const char* Ks, const char* Qs, int r32, int hi, const f32x16& negm, bool feat, bf16x8 qfeat, bf16x8 kfeat0, bf16x8 kfeat1) {
    bf16x8 qr[4];
#pragma unroll
    for (int d0 = 0; d0 < 4; ++d0) qr[d0] = *reinterpret_cast<const bf16x8*>(Qs + d0 * 1024);
#pragma unroll
    for (int d0 = 0; d0 < 4; ++d0) { const int cb = (d0 * 16 + hi * 8) * 2;
        const bf16x8 b0 = *reinterpret_cast<const bf16x8*>(Ks + KSWZ64(r32, cb));
        const bf16x8 b1 = *reinterpret_cast<const bf16x8*>(Ks + KSWZ64(32 + r32, cb));
        if (d0 == 0) { p0 = __builtin_amdgcn_mfma_f32_32x32x16_bf16(b0, qr[0], negm, 0, 0, 0); p1 = __builtin_amdgcn_mfma_f32_32x32x16_bf16(b1, qr[0], negm, 0, 0, 0); }
        else { p0 = __builtin_amdgcn_mfma_f32_32x32x16_bf16(b0, qr[d0], p0, 0, 0, 0); p1 = __builtin_amdgcn_mfma_f32_32x32x16_bf16(b1, qr[d0], p1, 0, 0, 0); } }
    if (feat) { p0 = __builtin_amdgcn_mfma_f32_32x32x16_bf16(kfeat0, qfeat, p0, 0, 0, 0); p1 = __builtin_amdgcn_mfma_f32_32x32x16_bf16(kfeat1, qfeat, p1, 0, 0, 0); }
}
__device__ __forceinline__ void partialSM_f(f32x16& p0, f32x16& p1, float& m_reg, float& alpha, f32x16& negm, bool diag, float dq, float nsl2) {
    if (diag) {
        asm volatile("" : "+v"(dq));
#pragma unroll
        for (int r = 0; r < 16; ++r) { const float c = (float)((r & 3) + 8 * (r >> 2)); p0[r] = fmaf(nsl2, fabsf(dq - c), p0[r]); p1[r] = fmaf(nsl2, fabsf(dq - (c + 32.f)), p1[r]); }
    }
    float pa = max3f(p0[0], p0[1], p1[0]), pb = max3f(p0[2], p0[3], p1[1]); pa = max3f(pa, p1[2], p1[3]);
#pragma unroll
    for (int r = 4; r < 16; r += 4) { pa = max3f(pa, p0[r], p0[r + 1]); pb = max3f(pb, p0[r + 2], p0[r + 3]); pa = max3f(pa, p1[r], p1[r + 1]); pb = max3f(pb, p1[r + 2], p1[r + 3]); }
    float pmax = fmaxf(pa, pb);
    { auto rr = __builtin_amdgcn_permlane32_swap(__float_as_uint(pmax), __float_as_uint(pmax), false, false);
      pmax = fmaxf(__uint_as_float(rr[0]), __uint_as_float(rr[1])); }
    alpha = 1.f;
    if (__builtin_expect(__any(pmax > THR2), 0)) {
        const float dl = pmax > THR2 ? pmax : 0.f;
        m_reg += dl; alpha = __builtin_amdgcn_exp2f(-dl);
#pragma unroll
        for (int r = 0; r < 16; ++r) { p0[r] -= dl; p1[r] -= dl; negm[r] = -m_reg; }
    }
#pragma unroll
    for (int r = 0; r < 16; ++r) p0[r] = __builtin_amdgcn_exp2f(p0[r]);
}
__device__ __forceinline__ void qkt(f32x16& p0, f32x16& p1, const char* Ks, const char* Qs, int r32, int hi) {
    p0 = f32x16{}; p1 = f32x16{};
    bf16x8 qr[4];
#pragma unroll
    for (int d0 = 0; d0 < 4; ++d0) qr[d0] = *reinterpret_cast<const bf16x8*>(Qs + d0 * 1024);
#pragma unroll
    for (int d0 = 0; d0 < 4; ++d0) { const int cb = (d0 * 16 + hi * 8) * 2;
        const bf16x8 b0 = *reinterpret_cast<const bf16x8*>(Ks + KSWZ64(r32, cb));
        const bf16x8 b1 = *reinterpret_cast<const bf16x8*>(Ks + KSWZ64(32 + r32, cb));
        p0 = __builtin_amdgcn_mfma_f32_32x32x16_bf16(b0, qr[d0], p0, 0, 0, 0);
        p1 = __builtin_amdgcn_mfma_f32_32x32x16_bf16(b1, qr[d0], p1, 0, 0, 0); }
}
#define TIDL() ({ int t_ = threadIdx.x; asm volatile("" : "+v"(t_)); t_; })
__device__ __forceinline__ float sumsq8(u32x4 w) { float s = bflo(w.x) * bflo(w.x); s = fmaf(bfhi(w.x), bfhi(w.x), s); s = fmaf(bflo(w.y), bflo(w.y), s); s = fmaf(bfhi(w.y), bfhi(w.y), s);
    s = fmaf(bflo(w.z), bflo(w.z), s); s = fmaf(bfhi(w.z), bfhi(w.z), s); s = fmaf(bflo(w.w), bflo(w.w), s); s = fmaf(bfhi(w.w), bfhi(w.w), s); return s; }
constexpr float SKIP_T2 = 44.f;
__device__ __forceinline__ void attn_pass(const bf16_t* __restrict__ Qw, const bf16_t* __restrict__ Kh, const bf16_t* __restrict__ Vh, const float* __restrict__ kn2g, char* lds, float qpos_f, float nsl2, int qb,
                                          f32x16 (&o)[4], float& l_out) {
    const int tid = tid_l(), wid = tid >> 6, lane = tid & 63, r32 = lane & 31, hi = lane >> 5;
    char* V_lds = lds + OFF_V; char* K_lds = lds + OFF_K;
    float m_reg = -1e30f, l_reg = 0.f;
#pragma unroll
    for (int d = 0; d < 4; ++d) o[d] = f32x16{};
    char* Qs = lds + OFF_OST + wid * 8192 + lane * 16;
    float* kn2 = (float*)(lds + OFF_NRM); float* qn2 = kn2 + 64;
    {
        float qs = 0.f, sd = 0.f;
        const bf16_t* Kd = Kh + (long)(qb * 256 + wid * QBLK + r32) * 512 + hi * 8;
#pragma unroll
        for (int d0 = 0; d0 < 4; ++d0) { const u32x4 w = *reinterpret_cast<const u32x4*>(Qw + d0 * 16); *reinterpret_cast<u32x4*>(Qs + d0 * 1024) = w; qs += sumsq8(w);
            const u32x4 kk = *reinterpret_cast<const u32x4*>(Kd + d0 * 16);
            sd += bflo(w.x) * bflo(kk.x) + bfhi(w.x) * bfhi(kk.x) + bflo(w.y) * bflo(kk.y) + bfhi(w.y) * bfhi(kk.y) + bflo(w.z) * bflo(kk.z) + bfhi(w.z) * bfhi(kk.z) + bflo(w.w) * bflo(kk.w) + bfhi(w.w) * bfhi(kk.w); }
        { auto rr = __builtin_amdgcn_permlane32_swap(__float_as_uint(qs), __float_as_uint(qs), false, false); qs = __uint_as_float(rr[0]) + __uint_as_float(rr[1]); }
        { auto rr = __builtin_amdgcn_permlane32_swap(__float_as_uint(sd), __float_as_uint(sd), false, false); sd = __uint_as_float(rr[0]) + __uint_as_float(rr[1]); }
        const float wm = wave_max(qs), wd = -wave_max(-sd);
        if (lane == 0) { qn2[wid] = wm; qn2[8 + wid] = wd; }
        float km = 0.f;
#pragma unroll
        for (int i = 0; i < 8; ++i) km = fmaxf(km, kn2g[(long)(tid * 8 + i) * 8]);
        km = fmaxf(km, swz_xor<1>(km)); km = fmaxf(km, swz_xor<2>(km)); km = fmaxf(km, swz_xor<4>(km));
        if ((tid & 7) == 0) kn2[tid >> 3] = km;
    }
    __syncthreads();
    int t_lo, t_hi; unsigned long long cmask;
    {
        float Qn2 = qn2[0], smin = qn2[8];
#pragma unroll
        for (int i = 1; i < 8; ++i) { Qn2 = fmaxf(Qn2, qn2[i]); smin = fminf(smin, qn2[8 + i]); }
        smin -= 0.05f + 1e-3f * fabsf(smin);
        const float Qn = sqrtf(Qn2) * 1.01f, Kt = sqrtf(kn2[lane]) * 1.01f;
        const int q0b = qb * 256, kt0 = lane * 64;
        const int dmin = (kt0 + 63 < q0b) ? (q0b - (kt0 + 63)) : ((kt0 > q0b + 255) ? (kt0 - (q0b + 255)) : 0);
        const bool need = !(Qn * Kt - smin + nsl2 * (float)dmin <= -SKIP_T2);
        cmask = __ballot(Qn * Kt > THR2);
        const unsigned long long mask = __ballot(need);
        t_lo = (int)__builtin_ctzll(mask); t_hi = 63 - (int)__builtin_clzll(mask);
        if (((t_hi - t_lo) & 1) == 0) { if (t_hi < 63) ++t_hi; else --t_lo; }
        t_lo = __builtin_amdgcn_readfirstlane(t_lo); t_hi = __builtin_amdgcn_readfirstlane(t_hi);
    }
    const int NTe = t_hi - t_lo + 1;
    Kh += (long)t_lo * KVBLK * 512; Vh += (long)t_lo * KVBLK * 512;
    unsigned kofs, vofs0, vofs1;
    { const int p = wid * 64 + lane, krow = p >> 3, kch = (p & 7) ^ ((krow >> 1) & 7); kofs = (unsigned)(krow * 512 + kch * 8) * 2u;
      const int l5 = lane & 31, kklo = l5 >> 2, cin = (lane & 3) * 8;
#pragma unroll
      for (int q = 0; q < 2; ++q) { const int sub = 2 * (2 * wid + q) + (lane >> 5), kkhi = sub >> 2, cblk = sub & 3, kk = kkhi * 8 + kklo, k = (kk & ~0xC) | ((kk & 4) << 1) | ((kk & 8) >> 1), c = cblk * 32 + cin;
          const unsigned v = (unsigned)(k * 512 + c) * 2u; if (q == 0) vofs0 = v; else vofs1 = v; } }
    const unsigned ldsK = (unsigned)__builtin_amdgcn_readfirstlane(wid * 1024), ldsV = (unsigned)__builtin_amdgcn_readfirstlane(wid * 2048);
    LAS unsigned char* lds3 = (LAS unsigned char*)(uintptr_t)(unsigned)(uintptr_t)lds;
#define DMA_K(t, slot) do { const int tt_ = (t) < NTe ? (t) : NTe - 1; __builtin_amdgcn_global_load_lds((const unsigned*)((const char*)Kh + (size_t)tt_ * (KVBLK * 512 * 2) + kofs), (LAS unsigned*)(lds3 + OFF_K + (slot) * SHM_K + ldsK), 16, 0, 0); } while (0)
#define DMA_V(t, slot) do { const int tt_ = (t) < NTe ? (t) : NTe - 1; const char* vb_ = (const char*)Vh + (size_t)tt_ * (KVBLK * 512 * 2); \
    __builtin_amdgcn_global_load_lds((const unsigned*)(vb_ + vofs0), (LAS unsigned*)(lds3 + OFF_V + (slot) * SHM_V + ldsV), 16, 0, 0); \
    __builtin_amdgcn_global_load_lds((const unsigned*)(vb_ + vofs1), (LAS unsigned*)(lds3 + OFF_V + (slot) * SHM_V + ldsV + 1024), 16, 0, 0); } while (0)
#define WAITBAR(n) do { asm volatile("s_waitcnt vmcnt(" #n ")" ::: "memory"); __builtin_amdgcn_s_barrier(); asm volatile("" ::: "memory"); } while (0)
#define VB(slot) ((int)(uintptr_t)V_lds + (slot) * SHM_V + v_rd_base(TIDL() & 63))
#define RESC(a) do { if (__any((a) < 1.f)) { const int t_ = TIDL(); float* al_l = (float*)(lds + OFF_WS) + (t_ >> 6) * 64 + 32; if (((t_ >> 5) & 1) == 0) al_l[t_ & 31] = (a); asm volatile("s_waitcnt lgkmcnt(0)" ::: "memory"); \
    _Pragma("unroll") for (int d = 0; d < 4; ++d) _Pragma("unroll") for (int r = 0; r < 16; ++r) o[d][r] *= al_l[crow(r, (t_ >> 5) & 1)]; } } while (0)
    m_reg = 0.f;
    f32x16 negm = f32x16{};
    bf16x8 qfeat, kfl0, kfl1; unsigned kf01, kf23, kfb0, kfb1;
    { const float sl2 = -nsl2; const float s_hi = bf2f((unsigned short)bf16_bits(sl2)), s_lo = bf2f((unsigned short)bf16_bits(sl2 - s_hi));
      const int qpos_i = (int)qpos_f; const float a_q = (float)(qpos_i >> 6), b_q = (float)(qpos_i & 63);
      const unsigned z = hi == 0 ? 0xffffffffu : 0u;
      u32x4 qf; qf.x = pack2(a_q, a_q) & z; qf.y = pack2(b_q, b_q) & z; qf.z = pack2(64.f * s_hi, 64.f * s_lo) & z; qf.w = pack2(s_hi, s_lo) & z; qfeat = __builtin_bit_cast(bf16x8, qf);
      kf01 = pack2(-64.f * s_hi, -64.f * s_lo) & z; kf23 = pack2(-s_hi, -s_lo) & z; kfb0 = pack2((float)r32, (float)r32) & z; kfb1 = pack2((float)(r32 + 32), (float)(r32 + 32)) & z; }
#define KFEAT(j) do { const int sd_ = SIDE(j); const float ak_ = (float)(t_lo + (j)); const unsigned sg_ = sd_ > 0 ? 0x80008000u : 0u, ka_ = (hi == 0 ? pack2(ak_, ak_) : 0u) ^ sg_; \
    u32x4 k0_ = {kf01 ^ sg_, kf23 ^ sg_, ka_, kfb0 ^ sg_}, k1_ = {kf01 ^ sg_, kf23 ^ sg_, ka_, kfb1 ^ sg_}; kfl0 = __builtin_bit_cast(bf16x8, k0_); kfl1 = __builtin_bit_cast(bf16x8, k1_); } while (0)
    const float dq0 = qpos_f - 4.f * hi - 64.f * (float)t_lo;
    const int tdw = __builtin_amdgcn_readfirstlane((qb * 256 + wid * QBLK) >> 6) - t_lo;
#define SIDE(j) ((j) < tdw ? -1 : ((j) > tdw ? 1 : 0))
    int s0 = 0, s1 = 1, s2 = 2;
#define ROT() do { const int t_ = s0; s0 = s1; s1 = s2; s2 = t_; } while (0)
    int kad[4];
#pragma unroll
    for (int d0 = 0; d0 < 4; ++d0) kad[d0] = (int)(uintptr_t)K_lds + KSWZ64(r32, (d0 * 16 + hi * 8) * 2);
    const int qad = (int)(uintptr_t)Qs;
    const int vad = (int)(uintptr_t)V_lds + v_rd_base(lane);
    bf16x8 fq0, fa0, fb0, fq1, fa1, fb1;
    s16x4 tv[8];
    f32x16 pA0, pA1, pB0, pB1; float alA = 1.f, alB = 1.f; bf16x8 pa0, pa1, pa2, pa3;
#define LR128(dst, addr, OFF) asm volatile("ds_read_b128 %0, %1 offset:%2" : "=&v"(dst) : "v"(addr), "i"(OFF) : "memory")
#define LRTR(dst, addr, OFF) asm volatile("ds_read_b64_tr_b16 %0, %1 offset:%2" : "=&v"(dst) : "v"(addr), "i"(OFF) : "memory")
#define LWAIT(n) do { asm volatile("s_waitcnt lgkmcnt(" #n ")" ::: "memory"); SBAR(); } while (0)
#define RDF0(d0, kso) do { LR128(fq0, qad, (d0) * 1024); const int ka_ = kad[d0] + (kso); LR128(fa0, ka_, 0); LR128(fb0, ka_, 4096); } while (0)
#define RDF1(d0, kso) do { LR128(fq1, qad, (d0) * 1024); const int ka_ = kad[d0] + (kso); LR128(fa1, ka_, 0); LR128(fb1, ka_, 4096); } while (0)
#define VRD(D0, va_) do { LRTR(tv[0], va_, v_rd_off(D0, 0, 0)); LRTR(tv[1], va_, v_rd_off(D0, 0, 1)); LRTR(tv[2], va_, v_rd_off(D0, 1, 0)); LRTR(tv[3], va_, v_rd_off(D0, 1, 1)); \
    LRTR(tv[4], va_, v_rd_off(D0, 2, 0)); LRTR(tv[5], va_, v_rd_off(D0, 2, 1)); LRTR(tv[6], va_, v_rd_off(D0, 3, 0)); LRTR(tv[7], va_, v_rd_off(D0, 3, 1)); } while (0)
#define TVK(k) (bf16x8){tv[2 * (k)][0], tv[2 * (k)][1], tv[2 * (k)][2], tv[2 * (k)][3], tv[2 * (k) + 1][0], tv[2 * (k) + 1][1], tv[2 * (k) + 1][2], tv[2 * (k) + 1][3]}
#define MF(acc, a, b, c) acc = __builtin_amdgcn_mfma_f32_32x32x16_bf16(a, b, c, 0, 0, 0)
#define PIN(x) asm volatile("" : "+v"(x))
#define SUM4(Y, B) do { sacc += Y[B]; sacc += Y[B + 1]; sacc += Y[B + 2]; sacc += Y[B + 3]; PIN(sacc); } while (0)
#define PKLO(Y, B) do { ca_ = cvt_pk_bf16(Y[B], Y[B + 1]); cb_ = cvt_pk_bf16(Y[B + 2], Y[B + 3]); } while (0)
#define PKHI(Y, B, OUT) do { const unsigned c0_ = cvt_pk_bf16(Y[B], Y[B + 1]), c1_ = cvt_pk_bf16(Y[B + 2], Y[B + 3]); \
    auto r0_ = __builtin_amdgcn_permlane32_swap(ca_, c0_, false, false); auto r1_ = __builtin_amdgcn_permlane32_swap(cb_, c1_, false, false); \
    u32x4 w_ = {r0_[0], r1_[0], r0_[1], r1_[1]}; OUT = __builtin_bit_cast(bf16x8, w_); PIN(OUT); } while (0)
#define CV4(Y, B, i) do { pk_[i] = cvt_pk_bf16(Y[B], Y[B + 1]); pk_[i + 1] = cvt_pk_bf16(Y[B + 2], Y[B + 3]); PIN(pk_[i]); PIN(pk_[i + 1]); } while (0)
#define SWP(i, OUT) do { auto r0_ = __builtin_amdgcn_permlane32_swap(pk_[i], pk_[i + 2], false, false); auto r1_ = __builtin_amdgcn_permlane32_swap(pk_[i + 1], pk_[i + 3], false, false); \
    u32x4 w_ = {r0_[0], r1_[0], r0_[1], r1_[1]}; OUT = __builtin_bit_cast(bf16x8, w_); PIN(OUT); } while (0)
#define VRDA(D0, va_) do { LRTR(tv[0], va_, v_rd_off(D0, 0, 0)); LRTR(tv[1], va_, v_rd_off(D0, 0, 1)); LRTR(tv[2], va_, v_rd_off(D0, 1, 0)); LRTR(tv[3], va_, v_rd_off(D0, 1, 1)); } while (0)
#define VRDB(D0, va_) do { LRTR(tv[4], va_, v_rd_off(D0, 2, 0)); LRTR(tv[5], va_, v_rd_off(D0, 2, 1)); LRTR(tv[6], va_, v_rd_off(D0, 3, 0)); LRTR(tv[7], va_, v_rd_off(D0, 3, 1)); } while (0)
#define MX3(m, a, b) do { m = __builtin_fmaxf(__builtin_fmaxf(m, a), b); } while (0)
#define EX3(X, a, b, c) do { float ea_ = EX(X[a]), eb_ = EX(X[b]), ec_ = EX(X[c]); asm volatile("" : "+v"(ea_), "+v"(eb_), "+v"(ec_)); X[a] = ea_; X[b] = eb_; X[c] = ec_; } while (0)
#define STEP(X0, X1, Y0, Y1, alY, alX, J, HAVE_PREV, DMAS) do { \
    const int kso_ = s1_cur * SHM_K, vso_ = vad + s0_cur * SHM_V; const int sd_ = SIDE(J); const bool feat_ = sd_ != 0; const bool chk_ = ((cmask >> (t_lo + (J))) & 1ull) != 0ull; \
    float sacc = 0.f; unsigned pk_[16]; \
    WAITBAR(3); \
    RDF0(0, kso_); RDF1(1, kso_); \
    DMAS; \
    KFEAT(J); \
    LWAIT(3); \
    MF(X0, fa0, fq0, negm); if (HAVE_PREV) { SUM4(Y0, 0); CV4(Y0, 0, 0); } SBAR(); \
    MF(X1, fb0, fq0, negm); if (HAVE_PREV) { SUM4(Y0, 4); CV4(Y0, 4, 2); } SBAR(); \
    RDF0(2, kso_); LWAIT(3); \
    MF(X0, fa1, fq1, X0); if (HAVE_PREV) { SUM4(Y0, 8); CV4(Y0, 8, 4); } SBAR(); \
    MF(X1, fb1, fq1, X1); if (HAVE_PREV) { SUM4(Y0, 12); CV4(Y0, 12, 6); } SBAR(); \
    RDF1(3, kso_); LWAIT(3); \
    MF(X0, fa0, fq0, X0); if (HAVE_PREV) { SUM4(Y1, 0); CV4(Y1, 0, 8); } SBAR(); \
    MF(X1, fb0, fq0, X1); if (HAVE_PREV) { SUM4(Y1, 4); CV4(Y1, 4, 10); } SBAR(); \
    LWAIT(0); \
    MF(X0, fa1, fq1, X0); if (HAVE_PREV) { SUM4(Y1, 8); CV4(Y1, 8, 12); } SBAR(); \
    MF(X1, fb1, fq1, X1); if (HAVE_PREV) { SUM4(Y1, 12); CV4(Y1, 12, 14); } SBAR(); \
    if (HAVE_PREV) VRD(0, vso_); \
    if (feat_) { MF(X0, kfl0, qfeat, X0); } \
    if (HAVE_PREV) { SWP(0, pa0); SWP(4, pa1); } SBAR(); \
    if (feat_) { MF(X1, kfl1, qfeat, X1); } \
    if (HAVE_PREV) { SWP(8, pa2); SWP(12, pa3); \
        auto rr_ = __builtin_amdgcn_permlane32_swap(__float_as_uint(sacc), __float_as_uint(sacc), false, false); l_reg = l_reg * (alY) + (__uint_as_float(rr_[0]) + __uint_as_float(rr_[1])); PIN(l_reg); } \
    SBAR(); \
    if (!feat_) { float dq_ = dq0 - 64.f * (float)(J); asm volatile("" : "+v"(dq_)); \
        _Pragma("unroll") for (int r = 0; r < 16; ++r) { const float c = (float)((r & 3) + 8 * (r >> 2)); X0[r] = fmaf(nsl2, fabsf(dq_ - c), X0[r]); X1[r] = fmaf(nsl2, fabsf(dq_ - (c + 32.f)), X1[r]); } } \
    SBAR(); \
    alX = 1.f; \
    if (__builtin_expect(chk_, 0)) {        \
        float ma_ = __builtin_fmaxf(__builtin_fmaxf(X0[0], X0[1]), X1[0]), mb_ = __builtin_fmaxf(__builtin_fmaxf(X0[2], X0[3]), X1[1]); ma_ = __builtin_fmaxf(__builtin_fmaxf(ma_, X1[2]), X1[3]); \
        _Pragma("unroll") for (int r = 4; r < 16; r += 4) { ma_ = __builtin_fmaxf(__builtin_fmaxf(ma_, X0[r]), X0[r + 1]); mb_ = __builtin_fmaxf(__builtin_fmaxf(mb_, X0[r + 2]), X0[r + 3]); \
            ma_ = __builtin_fmaxf(__builtin_fmaxf(ma_, X1[r]), X1[r + 1]); mb_ = __builtin_fmaxf(__builtin_fmaxf(mb_, X1[r + 2]), X1[r + 3]); } \
        float pm_ = __builtin_fmaxf(ma_, mb_); { auto rr_ = __builtin_amdgcn_permlane32_swap(__float_as_uint(pm_), __float_as_uint(pm_), false, false); pm_ = __builtin_fmaxf(__uint_as_float(rr_[0]), __uint_as_float(rr_[1])); } \
        if (__any(pm_ > THR2)) { const float dl_ = pm_ > THR2 ? pm_ : 0.f; m_reg += dl_; alX = __builtin_amdgcn_exp2f(-dl_); \
            _Pragma("unroll") for (int r = 0; r < 16; ++r) { X0[r] -= dl_; X1[r] -= dl_; negm[r] = -m_reg; } } } \
    SBAR(); \
    if (HAVE_PREV) { \
      LWAIT(0); MF(o[0], pa0, TVK(0), o[0]); EX2(X0, 0, 1); SBAR(); MF(o[0], pa1, TVK(1), o[0]); EX2(X0, 2, 3); SBAR(); VRDA(1, vso_); \
                MF(o[0], pa2, TVK(2), o[0]); EX2(X0, 4, 5); SBAR(); MF(o[0], pa3, TVK(3), o[0]); EX2(X0, 6, 7); SBAR(); VRDB(1, vso_); \
      LWAIT(4); MF(o[1], pa0, TVK(0), o[1]); EX2(X0, 8, 9); SBAR(); MF(o[1], pa1, TVK(1), o[1]); EX2(X0, 10, 11); SBAR(); VRDA(2, vso_); \
      LWAIT(4); MF(o[1], pa2, TVK(2), o[1]); EX2(X0, 12, 13); SBAR(); MF(o[1], pa3, TVK(3), o[1]); EX2(X0, 14, 15); SBAR(); VRDB(2, vso_); \
      LWAIT(4); MF(o[2], pa0, TVK(0), o[2]); EX2(X1, 0, 1); SBAR(); MF(o[2], pa1, TVK(1), o[2]); EX2(X1, 2, 3); SBAR(); VRDA(3, vso_); \
      LWAIT(4); MF(o[2], pa2, TVK(2), o[2]); EX2(X1, 4, 5); SBAR(); MF(o[2], pa3, TVK(3), o[2]); EX2(X1, 6, 7); SBAR(); VRDB(3, vso_); \
      LWAIT(4); MF(o[3], pa0, TVK(0), o[3]); EX2(X1, 8, 9); SBAR(); MF(o[3], pa1, TVK(1), o[3]); EX2(X1, 10, 11); SBAR(); \
      LWAIT(0); MF(o[3], pa2, TVK(2), o[3]); EX2(X1, 12, 13); SBAR(); MF(o[3], pa3, TVK(3), o[3]); EX2(X1, 14, 15); SBAR(); \
    } else { _Pragma("unroll") for (int r = 0; r < 16; ++r) { X0[r] = EX(X0[r]); X1[r] = EX(X1[r]); } } \
  } while (0)
#define EX(v) __builtin_amdgcn_exp2f(v)
#define EX2(X, a, b) do { float ea_ = EX(X[a]), eb_ = EX(X[b]); asm volatile("" : "+v"(ea_), "+v"(eb_)); X[a] = ea_; X[b] = eb_; } while (0)
    int s0_cur, s1_cur;
    asm volatile("s_waitcnt vmcnt(0) lgkmcnt(0)" ::: "memory"); __builtin_amdgcn_s_barrier();
    DMA_K(0, 0); DMA_V(0, 0); DMA_K(1, 1);
    s1_cur = s0; s0_cur = s0;
    STEP(pA0, pA1, pB0, pB1, alB, alA, 0, false, { DMA_K(2, s2); DMA_V(1, s1); });
    for (int j = 1; j + 1 < NTe; j += 2) {
        s1_cur = s1; s0_cur = s0;
        STEP(pB0, pB1, pA0, pA1, alA, alB, j, true, { DMA_K(j + 2, s0); DMA_V(j + 1, s2); });
        RESC(alB); ROT();
        s1_cur = s1; s0_cur = s0;
        STEP(pA0, pA1, pB0, pB1, alB, alA, j + 1, true, { DMA_K(j + 3, s0); DMA_V(j + 2, s2); });
        RESC(alA); ROT();
    }
    s1_cur = s1; s0_cur = s0;
    STEP(pB0, pB1, pA0, pA1, alA, alB, NTe - 1, true, { DMA_K(NTe, s0); DMA_V(NTe, s2); });
    RESC(alB); ROT();
    WAITBAR(0);
    { float sacc = 0.f; unsigned pk_[16];
      SUM4(pB0, 0); CV4(pB0, 0, 0); SUM4(pB0, 4); CV4(pB0, 4, 2); SUM4(pB0, 8); CV4(pB0, 8, 4); SUM4(pB0, 12); CV4(pB0, 12, 6);
      SUM4(pB1, 0); CV4(pB1, 0, 8); SUM4(pB1, 4); CV4(pB1, 4, 10); SUM4(pB1, 8); CV4(pB1, 8, 12); SUM4(pB1, 12); CV4(pB1, 12, 14);
      SWP(0, pa0); SWP(4, pa1); SWP(8, pa2); SWP(12, pa3);
      auto rr_ = __builtin_amdgcn_permlane32_swap(__float_as_uint(sacc), __float_as_uint(sacc), false, false); l_reg = l_reg * alB + (__uint_as_float(rr_[0]) + __uint_as_float(rr_[1])); }
    SBAR();
    pv_d0(o, VB(s0), pa0, pa1, pa2, pa3);
#undef LR128
#undef LRTR
#undef LWAIT
#undef RDF0
#undef RDF1
#undef VRD
#undef TVK
#undef MF
#undef PIN
#undef SUM4
#undef PKLO
#undef PKHI
#undef STEP
#undef EX
#undef EX2
#undef EX3
#undef CV4
#undef SWP
#undef VRDA
#undef VRDB
#undef MX3
    l_out = l_reg;
#undef DMA_K
#undef DMA_V
#undef WAITBAR
#undef RESC
#undef VB
#undef ROT
#undef SIDE
#undef KFEAT
}
__device__ __forceinline__ void attn_unit(int b, int h, int qb, const bf16_t* Q, const bf16_t* K, const bf16_t* V, const float* KN2, bf16_t* BR, float* park, const float* subln_g, float lam, char* lds) {
    const long rowbase = (long)b * SEQ;
    const float nsl2 = -exp2f(-2.f * (float)(h + 1)) * LOG2E;
    f32x16 o[4]; float l;
#pragma unroll 1
    for (int c = 0; c < 2; ++c) {
        {
            const int tid = tid_l(), wid = tid >> 6, lane = tid & 63, r32 = lane & 31, hi = lane >> 5;
            const int q0 = qb * 256 + wid * QBLK;
            const bf16_t* Qw = Q + (rowbase + q0 + r32) * 512 + h * 128 + c * 64 + hi * 8;
            const bf16_t* Kh = K + rowbase * 512 + h * 128 + c * 64;
            const bf16_t* Vh = V + rowbase * 512 + h * 128;
            attn_pass(Qw, Kh, Vh, KN2 + rowbase * 8 + h * 2 + c, lds, (float)(q0 + r32), nsl2, qb, o, l);
        }
        int tid = threadIdx.x; asm volatile("" : "+v"(tid));
        const int wid = __builtin_amdgcn_readfirstlane(tid >> 6), lane = tid & 63, r32 = lane & 31, hi = lane >> 5;
        float* ws = (float*)(lds + OFF_WS) + wid * 64;
        if (hi == 0) ws[r32] = l; asm volatile("s_waitcnt lgkmcnt(0)" ::: "memory");
        float rli[16];
#pragma unroll
        for (int r = 0; r < 16; ++r) rli[r] = __builtin_amdgcn_rcpf(ws[crow(r, hi)]);
        float* pkl = park + (size_t)wid * 64 * 64 + lane;
        if (c == 0) {
#pragma unroll
            for (int d0 = 0; d0 < 4; ++d0) { float* pp = pkl + d0 * 16 * 64; asm volatile("" : "+v"(pp));
#pragma unroll
                for (int r = 0; r < 16; ++r) pp[r * 64] = o[d0][r] * rli[r]; }
            asm volatile("s_waitcnt vmcnt(0)" ::: "memory");
        } else {
            float ss[16];
#pragma unroll
            for (int r = 0; r < 16; ++r) ss[r] = 0.f;
#pragma unroll
            for (int d0 = 0; d0 < 4; ++d0) { const float* pp = pkl + d0 * 16 * 64; asm volatile("" : "+v"(pp));
#pragma unroll
                for (int r = 0; r < 16; ++r) { const float dv = pp[r * 64] - lam * (o[d0][r] * rli[r]); o[d0][r] = dv; ss[r] += dv * dv; } }
#pragma unroll
            for (int r = 0; r < 16; ++r) {
                ss[r] = half_sum(ss[r]);
                ss[r] = rsqrtf(ss[r] * (1.f / 128.f) + EPS) * 0.8f; }
            float gsub[4];
#pragma unroll
            for (int d0 = 0; d0 < 4; ++d0) gsub[d0] = subln_g[d0 * 32 + r32];
            const int q0 = qb * 256 + wid * QBLK;
            bf16_t* Ow = BR + (rowbase + q0) * 1024 + h * 128 + (long)(lane >> 4) * 1024 + (lane & 15) * 8;
            bf16_t* stg = (bf16_t*)(lds + OFF_OST) + wid * (32 * 128);
            bf16_t* sw = stg + (4 * hi) * 128 + r32;
#pragma unroll
            for (int r = 0; r < 16; ++r) {
#pragma unroll
                for (int d0 = 0; d0 < 4; ++d0) { const unsigned w = cvt_pk_bf16(o[d0][r] * ss[r] * gsub[d0], 0.f); sw[((r & 3) + 8 * (r >> 2)) * 128 + d0 * 32] = (bf16_t)(w & 0xffffu); } }
            asm volatile("s_waitcnt lgkmcnt(0)" ::: "memory");
#pragma unroll
            for (int i = 0; i < 8; ++i) { const int row = i * 4 + (lane >> 4), ch = lane & 15; const u32x4 v = *(const u32x4*)(stg + row * 128 + ch * 8); *(u32x4*)(Ow + (long)i * 4096) = v; }
        }
        __syncthreads();
    }
}
__device__ __forceinline__ void attn_naive(Frame& F, const bf16_t* Q, const bf16_t* K, const bf16_t* V, bf16_t* BR, const float* subln_g, float lam) {
    const int gw = F.vcu * NWAVES + F.wave, NGW = F.G * NWAVES, lane = F.lane;
    for (int item = gw; item < MTOK * 4; item += NGW) {
        const int row = item >> 2, h = item & 3, b = row >> 12, qpos = row & 4095;
        const float sl2 = exp2f(-2.f * (float)(h + 1)) * LOG2E;
        float res0 = 0.f, res1 = 0.f;
        for (int c = 0; c < 2; ++c) {
            const bf16_t* qp = Q + (size_t)row * 512 + h * 128 + c * 64;
            float m = -1e30f, l = 0.f, o0 = 0.f, o1 = 0.f;
            for (int j0 = 0; j0 < SEQ; j0 += 64) {
                const int j = j0 + lane;
                const bf16_t* kp = K + ((size_t)b * SEQ + j) * 512 + h * 128 + c * 64;
                float s = 0.f;
                for (int d = 0; d < 64; d += 8) { const u32x4 qv = *(const u32x4*)(qp + d), kv = *(const u32x4*)(kp + d);
                    s += bflo(qv.x) * bflo(kv.x) + bfhi(qv.x) * bfhi(kv.x) + bflo(qv.y) * bflo(kv.y) + bfhi(qv.y) * bfhi(kv.y) + bflo(qv.z) * bflo(kv.z) + bfhi(qv.z) * bfhi(kv.z) + bflo(qv.w) * bflo(kv.w) + bfhi(qv.w) * bfhi(kv.w); }
                s -= sl2 * fabsf((float)(qpos - j));
                const float mn = fmaxf(m, wave_max(s)), f = exp2f(m - mn), pj = exp2f(s - mn);
                l = l * f + wave_sum(pj); o0 *= f; o1 *= f; m = mn;
                const bf16_t* vp = V + ((size_t)b * SEQ + j0) * 512 + h * 128 + lane * 2;
                for (int t = 0; t < 64; ++t) { const float pt = __shfl(pj, t); const unsigned vv = *(const unsigned*)(vp + (size_t)t * 512); o0 = fmaf(pt, bflo(vv), o0); o1 = fmaf(pt, bfhi(vv), o1); }
            }
            const float il = 1.f / l;
            if (c == 0) { res0 = o0 * il; res1 = o1 * il; } else { res0 -= lam * o0 * il; res1 -= lam * o1 * il; }
        }
        const float ss = wave_sum(res0 * res0 + res1 * res1);
        const float r = rsqrtf(ss * (1.f / 128.f) + EPS) * 0.8f;
        *(unsigned*)(BR + (size_t)row * 1024 + h * 128 + lane * 2) = cvt_pk_bf16(res0 * r * subln_g[lane * 2], res1 * r * subln_g[lane * 2 + 1]);
    }
}
__device__ __forceinline__ void sgu_item(int item, const bf16_t* U, const bf16_t* Sx, const bf16_t* Wsb, const float* ln_g, const float* ln_b, const float* bs, bf16_t* BR, char* lds) {
    const int tid = tid_l(), wid = tid >> 6, lane = tid & 63, r32 = lane & 31, hi = lane >> 5;
    const long row0 = (long)item * 128;
    float lg[8], lb[8];
#pragma unroll
    for (int j = 0; j < 8; ++j) { lg[j] = ln_g[lane * 8 + j]; lb[j] = ln_b[lane * 8 + j]; }
    const int g_l = lane >> 4, d_l = (lane & 15) * 8;
    {
        u32x4 raw[16]; float sm[16], sq[16];
#pragma unroll
        for (int t = 0; t < 16; ++t) raw[t] = *(const u32x4*)(Sx + (row0 + wid * 16 + t) * 512 + lane * 8);
#pragma unroll
        for (int t = 0; t < 16; ++t) { const u32x4 r_ = raw[t];
            const float v[8] = {bflo(r_.x), bfhi(r_.x), bflo(r_.y), bfhi(r_.y), bflo(r_.z), bfhi(r_.z), bflo(r_.w), bfhi(r_.w)};
            float a = 0.f, q = 0.f;
#pragma unroll
            for (int j = 0; j < 8; ++j) { a += v[j]; q = fmaf(v[j], v[j], q); }
            sm[t] = a; sq[t] = q; }
#pragma unroll
        for (int t = 0; t < 16; ++t) { sm[t] = half_sum(sm[t]); sq[t] = half_sum(sq[t]); }
#pragma unroll
        for (int t = 0; t < 16; ++t) {
            const float s_all = __int_as_float(__builtin_amdgcn_readlane(__float_as_int(sm[t]), 0)) + __int_as_float(__builtin_amdgcn_readlane(__float_as_int(sm[t]), 32));
            const float q_all = __int_as_float(__builtin_amdgcn_readlane(__float_as_int(sq[t]), 0)) + __int_as_float(__builtin_amdgcn_readlane(__float_as_int(sq[t]), 32));
            const float mu = s_all * (1.f / 512.f), var = fmaxf(q_all * (1.f / 512.f) - mu * mu, 0.f), rstd = rsqrtf(var + EPS), nm = -mu * rstd;
            const int s = wid * 16 + t; const u32x4 r_ = raw[t];
            const float v[8] = {bflo(r_.x), bfhi(r_.x), bflo(r_.y), bfhi(r_.y), bflo(r_.z), bfhi(r_.z), bflo(r_.w), bfhi(r_.w)};
            float o[8];
#pragma unroll
            for (int j = 0; j < 8; ++j) o[j] = fmaf(fmaf(v[j], rstd, nm), lg[j], lb[j]);
            u32x4 w; w.x = cvt_pk_bf16(o[0], o[1]); w.y = cvt_pk_bf16(o[2], o[3]); w.z = cvt_pk_bf16(o[4], o[5]); w.w = cvt_pk_bf16(o[6], o[7]);
            *(u32x4*)(lds + g_l * 32768 + (s >> 6) * 16384 + v_st(s & 63, d_l)) = w;
        }
    }
    __syncthreads();
    const int g = wid >> 1;
    const int vb0 = (int)(uintptr_t)lds + g * 32768 + v_rd_base(lane);
    f32x16 oa[4], ob[4];
#pragma unroll
    for (int d = 0; d < 4; ++d) { oa[d] = f32x16{}; ob[d] = f32x16{}; }
    {
        const bf16_t* wrow = Wsb + ((size_t)g * 128 + 64 * (wid & 1) + r32) * 128 + hi * 8;
#pragma unroll
        for (int T = 0; T < 2; ++T) {
            const bf16x8 pa0 = *reinterpret_cast<const bf16x8*>(wrow + T * 64 + 0), pa1 = *reinterpret_cast<const bf16x8*>(wrow + T * 64 + 16);
            const bf16x8 pa2 = *reinterpret_cast<const bf16x8*>(wrow + T * 64 + 32), pa3 = *reinterpret_cast<const bf16x8*>(wrow + T * 64 + 48);
            pv_d0(oa, vb0 + T * 16384, pa0, pa1, pa2, pa3);
        }
        const bf16_t* wrow2 = wrow + 32 * 128;
#pragma unroll
        for (int T = 0; T < 2; ++T) {
            const bf16x8 pa0 = *reinterpret_cast<const bf16x8*>(wrow2 + T * 64 + 0), pa1 = *reinterpret_cast<const bf16x8*>(wrow2 + T * 64 + 16);
            const bf16x8 pa2 = *reinterpret_cast<const bf16x8*>(wrow2 + T * 64 + 32), pa3 = *reinterpret_cast<const bf16x8*>(wrow2 + T * 64 + 48);
            pv_d0(ob, vb0 + T * 16384, pa0, pa1, pa2, pa3);
        }
    }
    __syncthreads();
    bf16_t* stg = (bf16_t*)(lds + wid * 16384);
    {
        const int t0 = 64 * (wid & 1);
        bf16_t* sw = stg + (4 * hi) * 128 + r32;
#pragma unroll
        for (int r = 0; r < 16; ++r) { const int rr = (r & 3) + 8 * (r >> 2); const float ba = bs[g * 128 + t0 + rr + 4 * hi], bb = bs[g * 128 + t0 + 32 + rr + 4 * hi];
#pragma unroll
            for (int d0 = 0; d0 < 4; ++d0) { sw[rr * 128 + d0 * 32] = (bf16_t)(cvt_pk_bf16(oa[d0][r] + ba, 0.f) & 0xffffu); sw[(32 + rr) * 128 + d0 * 32] = (bf16_t)(cvt_pk_bf16(ob[d0][r] + bb, 0.f) & 0xffffu); } }
        asm volatile("s_waitcnt lgkmcnt(0)" ::: "memory");
#pragma unroll
        for (int i = 0; i < 16; ++i) { const int row = i * 4 + (lane >> 4), ch = lane & 15; const long tok = row0 + t0 + row; const int c = g * 128 + ch * 8;
            const u32x4 z = *(const u32x4*)(stg + row * 128 + ch * 8), uu = *(const u32x4*)(U + tok * 512 + c);
            u32x4 w; w.x = cvt_pk_bf16(bflo(uu.x) * bflo(z.x), bfhi(uu.x) * bfhi(z.x)); w.y = cvt_pk_bf16(bflo(uu.y) * bflo(z.y), bfhi(uu.y) * bfhi(z.y));
            w.z = cvt_pk_bf16(bflo(uu.z) * bflo(z.z), bfhi(uu.z) * bfhi(z.z)); w.w = cvt_pk_bf16(bflo(uu.w) * bflo(z.w), bfhi(uu.w) * bfhi(z.w));
            *(u32x4*)(BR + tok * 1024 + 512 + c) = w; }
    }
    __syncthreads();
}
__device__ __forceinline__ void sgu_naive(int item, const bf16_t* U, const bf16_t* Sx, const float* Wsf, const float* ln_g, const float* ln_b, const float* bs, bf16_t* BR, char* lds) {
    const int tid = tid_l(), wid = tid >> 6, lane = tid & 63;
    const long row0 = (long)item * 128;
    bf16_t* sn = (bf16_t*)lds;
    for (int t = 0; t < 16; ++t) {
        const int s = wid * 16 + t;
        const u32x4 raw = *(const u32x4*)(Sx + (row0 + s) * 512 + lane * 8);
        float v[8] = {bflo(raw.x), bfhi(raw.x), bflo(raw.y), bfhi(raw.y), bflo(raw.z), bfhi(raw.z), bflo(raw.w), bfhi(raw.w)};
        float sm = 0.f;
        for (int j = 0; j < 8; ++j) sm += v[j];
        const float mu = wave_sum(sm) * (1.f / 512.f);
        float q = 0.f;
        for (int j = 0; j < 8; ++j) { v[j] -= mu; q += v[j] * v[j]; }
        const float rstd = rsqrtf(wave_sum(q) * (1.f / 512.f) + EPS);
        for (int j = 0; j < 8; ++j) sn[s * 512 + lane * 8 + j] = (bf16_t)(cvt_pk_bf16(v[j] * rstd * ln_g[lane * 8 + j] + ln_b[lane * 8 + j], 0.f) & 0xffffu);
    }
    __syncthreads();
    const int c = tid, g = c >> 7;
    for (int t = 0; t < 128; ++t) {
        float acc = 0.f;
        for (int s = 0; s < 128; ++s) acc = fmaf(Wsf[((size_t)g * 128 + t) * 128 + s], bf2f(sn[s * 512 + c]), acc);
        acc += bs[g * 128 + t];
        BR[(row0 + t) * 1024 + 512 + c] = (bf16_t)(cvt_pk_bf16(bf2f(U[(row0 + t) * 512 + c]) * acc, 0.f) & 0xffffu);
    }
    __syncthreads();
}
}

__device__ __forceinline__ void p5_router(Frame& F) {
    const int gw = F.vcu * NWAVES + F.wave, NGW = F.G * NWAVES, lane = F.lane, n16 = lane & 15, kq = lane >> 4;
    const float* g = F.in[16]; const float* wr = F.in[17];
    unsigned char* H2 = (unsigned char*)(F.ws + WS_H2); float* aff = (float*)(F.ws + WS_AFF);
    constexpr int OFF_G = 65536, OFF_R = OFF_G + 4096, NBATCH = MTOK / 16;
    int bi = gw;
    u32x4 a[32];
#define P5_LOAD() do { const u32x4* xp = (const u32x4*)((const bf16_t*)(F.ws + WS_X1B) + (size_t)(16 * bi + n16) * DM + 8 * kq); \
    _Pragma("unroll") for (int t = 0; t < 32; ++t) a[t] = xp[4 * t]; } while (0)
    if (bi < NBATCH) P5_LOAD();
    for (int c = F.tid; c < 32 * 64; c += NTHREADS) {
        const int t = c >> 6, l = c & 63, n = l & 15, q = l >> 4, k0 = 32 * t + 8 * q;
        float w[8], lo[8];
#pragma unroll
        for (int j = 0; j < 8; ++j) { w[j] = g[k0 + j] * wr[(size_t)(k0 + j) * 16 + n]; lo[j] = w[j] - bf2f((unsigned short)att::bf16_bits(w[j])); }
        u32x4 h4, l4;
        h4.x = pk2(w[0], w[1]); h4.y = pk2(w[2], w[3]); h4.z = pk2(w[4], w[5]); h4.w = pk2(w[6], w[7]);
        l4.x = pk2(lo[0], lo[1]); l4.y = pk2(lo[2], lo[3]); l4.z = pk2(lo[4], lo[5]); l4.w = pk2(lo[6], lo[7]);
        *(LAS u32x4*)(F.lds + (t * 2 + 0) * 1024 + l * 16) = h4;
        *(LAS u32x4*)(F.lds + (t * 2 + 1) * 1024 + l * 16) = l4;
    }
    for (int c = F.tid; c < DM / 4; c += NTHREADS) *(LAS f32x4*)(F.lds + OFF_G + c * 16) = *(const f32x4*)(g + c * 4);
    __syncthreads();
    while (bi < NBATCH) {
        const int r0 = 16 * bi;
        const LAS u32x4* wl = (const LAS u32x4*)F.lds + lane; asm volatile("" : "+v"(wl));
        f32x4 chi = {0.f, 0.f, 0.f, 0.f}, clo = {0.f, 0.f, 0.f, 0.f}; float ss = 0.f;
        u32x4 bh = wl[0], bl = wl[64];
#pragma unroll
        for (int t = 0; t < 32; ++t) {
            u32x4 nh = bh, nl = bl;
            if (t < 31) { nh = wl[(t * 2 + 2) * 64]; nl = wl[(t * 2 + 3) * 64]; }
            chi = __builtin_amdgcn_mfma_f32_16x16x32_bf16(__builtin_bit_cast(bf16x8, a[t]), __builtin_bit_cast(bf16x8, bh), chi, 0, 0, 0);
            clo = __builtin_amdgcn_mfma_f32_16x16x32_bf16(__builtin_bit_cast(bf16x8, a[t]), __builtin_bit_cast(bf16x8, bl), clo, 0, 0, 0);
            ss += att::sumsq8(a[t]);
            bh = nh; bl = nl;
            SBAR();
        }
        int l2 = threadIdx.x; asm volatile("" : "+v"(l2)); l2 &= 63;
        const int n16 = l2 & 15, kq = l2 >> 4;
        ss += swz_xor<16>(ss);
        { auto rr = __builtin_amdgcn_permlane32_swap(__float_as_uint(ss), __float_as_uint(ss), false, false); ss = __uint_as_float(rr[0]) + __uint_as_float(rr[1]); }
        const float r = rsqrtf(ss * (1.f / DM) + EPS);
        LAS float* rl = (LAS float*)(F.lds + OFF_R) + F.wave * 16;
        if (kq == 0) rl[n16] = r;
        asm volatile("s_waitcnt lgkmcnt(0)" ::: "memory");
        const f32x4 r4 = *(const LAS f32x4*)(rl + 4 * kq);
        asm volatile("s_waitcnt lgkmcnt(0)" ::: "memory");
#pragma unroll
        for (int i = 0; i < 4; ++i) {
            const float t = (chi[i] + clo[i]) * r4[i];
            float mx = fmaxf(t, swz_xor<1>(t)); mx = fmaxf(mx, swz_xor<2>(mx)); mx = fmaxf(mx, swz_xor<4>(mx)); mx = fmaxf(mx, swz_xor<8>(mx));
            const float ex = __builtin_amdgcn_exp2f((t - mx) * LOG2E);
            float den = ex + swz_xor<1>(ex); den += swz_xor<2>(den); den += swz_xor<4>(den); den += swz_xor<8>(den);
            aff[(size_t)(r0 + 4 * kq + i) * 16 + n16] = ex / den;
        }
        const float rs = r * MOE_HSCALE;
        unsigned char* hp = H2 + (size_t)(r0 + n16) * DM + 8 * kq;
        const LAS f32x4* gl = (const LAS f32x4*)(F.lds + OFF_G) + 2 * kq; asm volatile("" : "+v"(gl));
#pragma unroll
        for (int t = 0; t < 32; ++t) {
            const f32x4 g0 = gl[8 * t], g1 = gl[8 * t + 1]; u32x4 w = a[t]; asm volatile("" : "+v"(w));
            int p0 = 0, p1 = 0;
            p0 = __builtin_amdgcn_cvt_pk_fp8_f32(bflo(w.x) * rs * g0.x, bfhi(w.x) * rs * g0.y, p0, false); p0 = __builtin_amdgcn_cvt_pk_fp8_f32(bflo(w.y) * rs * g0.z, bfhi(w.y) * rs * g0.w, p0, true);
            p1 = __builtin_amdgcn_cvt_pk_fp8_f32(bflo(w.z) * rs * g1.x, bfhi(w.z) * rs * g1.y, p1, false); p1 = __builtin_amdgcn_cvt_pk_fp8_f32(bflo(w.w) * rs * g1.z, bfhi(w.w) * rs * g1.w, p1, true);
            u32x2 o; o.x = (unsigned)p0; o.y = (unsigned)p1; *(u32x2*)(hp + 32 * t) = o;
            SBAR();
        }
        bi += NGW;
        if (bi < NBATCH) P5_LOAD();
    }
#undef P5_LOAD
    __syncthreads();
}

__device__ __forceinline__ void p6_topk(Frame& F, int first) {
    LAS unsigned* hist = (LAS unsigned*)F.lds;
    LAS unsigned* shv = (LAS unsigned*)(F.lds + 1024);
    const float* aff = (const float*)(F.ws + WS_AFF);
    int* idx = (int*)(F.ws + WS_IDX); float* gv = (float*)(F.ws + WS_GV); int* inv = (int*)(F.ws + WS_INV);
    const int tid = F.tid, lane = F.lane, w = F.wave;
    for (int item = first; item < NB * NE; item += F.G) {
        const int b = item >> 4, e = item & 15;
        unsigned key[8];
#pragma unroll
        for (int i = 0; i < 8; ++i) key[i] = __float_as_uint(aff[((size_t)b * SEQ + tid * 8 + i) * 16 + e]);
        unsigned prefix = 0, remain = CAP;
        for (int pass = 0; pass < 4; ++pass) {
            const int shift = 24 - 8 * pass;
            if (tid < 256) hist[tid] = 0;
            __syncthreads();
            const unsigned himask = pass == 0 ? 0u : (0xFFFFFFFFu << (shift + 8));
#pragma unroll
            for (int i = 0; i < 8; ++i) if ((key[i] & himask) == prefix) atomicAdd((unsigned*)&hist[(key[i] >> shift) & 255u], 1u);
            __syncthreads();
            if (w == 0) {
                const unsigned h0 = hist[4 * lane], h1 = hist[4 * lane + 1], h2 = hist[4 * lane + 2], h3 = hist[4 * lane + 3];
                const unsigned t = h0 + h1 + h2 + h3; unsigned v = t;
#pragma unroll
                for (int o = 1; o < 64; o <<= 1) { const unsigned n = __shfl_down(v, o); if (lane + o < 64) v += n; }
                unsigned above = v - t;
                const unsigned hh[4] = {h0, h1, h2, h3};
#pragma unroll
                for (int q = 3; q >= 0; --q) { if (above < remain && above + hh[q] >= remain) { shv[0] = prefix | ((unsigned)(4 * lane + q) << shift); shv[1] = remain - above; } above += hh[q]; }
            }
            __syncthreads();
            prefix = shv[0]; remain = shv[1];
            __syncthreads();
        }
        const unsigned T = prefix;
        unsigned ngt = 0, neq = 0;
#pragma unroll
        for (int i = 0; i < 8; ++i) { ngt += key[i] > T; neq += key[i] == T; }
        unsigned pg = ngt, pe = neq;
#pragma unroll
        for (int o = 1; o < 64; o <<= 1) { const unsigned a = __shfl_up(pg, o), c = __shfl_up(pe, o); if (lane >= o) { pg += a; pe += c; } }
        if (lane == 63) { shv[8 + w] = pg; shv[16 + w] = pe; }
        __syncthreads();
        unsigned bg = 0, be = 0;
        for (int i = 0; i < w; ++i) { bg += shv[8 + i]; be += shv[16 + i]; }
        unsigned eg = bg + pg - ngt, ee = be + pe - neq;
#pragma unroll
        for (int i = 0; i < 8; ++i) {
            const int s = tid * 8 + i;
            int slot = -1;
            if (key[i] > T) { slot = (int)(eg + min(ee, remain)); ++eg; }
            else if (key[i] == T) { if (ee < remain) slot = (int)(eg + ee); ++ee; }
            inv[((size_t)b * SEQ + s) * 16 + e] = slot;
            if (slot >= 0) { idx[item * CAP + slot] = s; gv[item * CAP + slot] = __uint_as_float(key[i]); }
        }
        __syncthreads();
    }
}

__device__ __forceinline__ void p9_final(Frame& F, float* dst) {
    const int gw = F.vcu * NWAVES + F.wave, NGW = F.G * NWAVES, lane = F.lane;
    const float* g = F.in[21]; const unsigned char* Y = (const unsigned char*)(F.ws + WS_Y); const int* inv = (const int*)(F.ws + WS_INV);
    f32x4 gg[4];
#pragma unroll
    for (int j = 0; j < 4; ++j) gg[j] = *(const f32x4*)(g + (lane + 64 * j) * 4);
    u32x2 nx[4]; int nslot = -1;
#define P9_PREF(row) do { const u32x2* xr_ = (const u32x2*)((const bf16_t*)(F.ws + WS_X1B) + (size_t)(row) * DM) + lane; \
    _Pragma("unroll") for (int j = 0; j < 4; ++j) nx[j] = xr_[64 * j]; nslot = lane < 16 ? inv[(size_t)(row) * 16 + lane] : -1; } while (0)
    if (gw < MTOK) P9_PREF(gw);
    for (int row = gw; row < MTOK; row += NGW) {
        f32x4 v[4];
#pragma unroll
        for (int j = 0; j < 4; ++j) v[j] = (f32x4){bflo(nx[j].x), bfhi(nx[j].x), bflo(nx[j].y), bfhi(nx[j].y)};
        const int myslot = nslot;
        if (row + NGW < MTOK) P9_PREF(row + NGW);
        const int b = row >> 12;
        unsigned long long mask = __ballot(myslot >= 0);
        const unsigned char* Yb = Y + (size_t)b * NE * CAP * DM;
        while (mask) {
            const int e0 = (int)__builtin_ctzll(mask); mask &= mask - 1;
            const int e1 = mask ? (int)__builtin_ctzll(mask) : e0; const bool two = mask != 0; mask &= mask - 1;
            const int s0 = __builtin_amdgcn_readlane(myslot, e0), s1 = __builtin_amdgcn_readlane(myslot, e1);
            const int* y0 = (const int*)(Yb + ((size_t)e0 * CAP + s0) * DM) + lane; const int* y1 = (const int*)(Yb + ((size_t)e1 * CAP + s1) * DM) + lane;
            int t0[4], t1[4];
#pragma unroll
            for (int j = 0; j < 4; ++j) { t0[j] = y0[64 * j]; t1[j] = y1[64 * j]; }
            const float sc1 = two ? 1.f / MOE_YSCALE : 0.f;
#pragma unroll
            for (int j = 0; j < 4; ++j) {
                const f32x2 lo = __builtin_amdgcn_cvt_pk_f32_fp8(t0[j], false), hi = __builtin_amdgcn_cvt_pk_f32_fp8(t0[j], true);
                v[j].x = fmaf(lo.x, 1.f / MOE_YSCALE, v[j].x); v[j].y = fmaf(lo.y, 1.f / MOE_YSCALE, v[j].y); v[j].z = fmaf(hi.x, 1.f / MOE_YSCALE, v[j].z); v[j].w = fmaf(hi.y, 1.f / MOE_YSCALE, v[j].w);
                const f32x2 lo1 = __builtin_amdgcn_cvt_pk_f32_fp8(t1[j], false), hi1 = __builtin_amdgcn_cvt_pk_f32_fp8(t1[j], true);
                v[j].x = fmaf(lo1.x, sc1, v[j].x); v[j].y = fmaf(lo1.y, sc1, v[j].y); v[j].z = fmaf(hi1.x, sc1, v[j].z); v[j].w = fmaf(hi1.y, sc1, v[j].w);
            }
        }
        float s = 0.f;
#pragma unroll
        for (int j = 0; j < 4; ++j) s += (v[j].x * v[j].x + v[j].y * v[j].y) + (v[j].z * v[j].z + v[j].w * v[j].w);
        const float r = rsqrtf(wave_sum(s) * (1.f / DM) + EPS);
        f32x4* xw = (f32x4*)(dst + (size_t)row * DM) + lane;
#pragma unroll
        for (int j = 0; j < 4; ++j) { f32x4 w = {v[j].x * r * gg[j].x, v[j].y * r * gg[j].y, v[j].z * r * gg[j].z, v[j].w * r * gg[j].w}; xw[64 * j] = w; }
    }
#undef P9_PREF
}

__global__ void __launch_bounds__(NTHREADS, 2) fwd_kernel(Args args) {
    extern __shared__ __attribute__((aligned(16))) unsigned char lds[];
    Frame F;
    F.lds = (LAS unsigned char*)lds; F.ldsg = lds;
    F.tid = threadIdx.x; F.lane = F.tid & 63; F.wave = __builtin_amdgcn_readfirstlane(F.tid >> 6);
    F.G = gridDim.x; { const int bx = blockIdx.x; F.vcu = (F.G % 8 == 0) ? (bx % 8) * (F.G / 8) + bx / 8 : bx; }
#pragma unroll
    for (int i = 0; i < 22; ++i) F.in[i] = args.in[i];
    F.out = args.out; F.ws = args.ws;
    volatile LAS unsigned* MISC = (volatile LAS unsigned*)(F.lds + MISC_OFF);
    for (int u = F.tid; u < (LDS_BYTES - LDSCTL_OFF) / 4; u += NTHREADS) ((LAS unsigned*)(F.lds + LDSCTL_OFF))[u] = 0u;
    __syncthreads();
    unsigned* ctl = (unsigned*)(F.ws + WS_CTL);
    const int lo = args.ph_lo, hi = args.ph_hi;
    XcdBarrier bar; bar.bar = ctl + CW_BAR; bar.x = 0; bar.st = nullptr;
    if (hi - lo > 1) {
        if (F.tid == 0 && xb_xcc_id() != ((unsigned)blockIdx.x & 7u)) atomicOr(ctl + CW_BAR + XB_MISPLACED, 1u);
        bar = xcd_barrier_post(ctl + CW_BAR, MISC + 8);
    }
#ifndef PHASE_MASK
#define PHASE_MASK 0x3ff
#endif
#define IN(k) (((PHASE_MASK >> (k)) & 1) && lo <= (k) && (k) < hi)
#define REFRESH() do { int t_ = threadIdx.x; asm volatile("" : "+v"(t_)); F.tid = t_; F.lane = t_ & 63; F.wave = __builtin_amdgcn_readfirstlane(t_ >> 6); } while (0)
#ifndef XCC_LOCAL_SEAMS
#define XCC_LOCAL_SEAMS 1
#endif
#define SEAM(k) do { if (IN(k) && IN((k) + 1)) xcd_barrier(bar); } while (0)
#define SEAML(k) do { if (IN(k) && IN((k) + 1)) { if (fastx) xcd_local_barrier(bar); else xcd_barrier(bar); } } while (0)

    bf16_t* XN = (bf16_t*)((unsigned char*)F.out + DO_XN);
    bf16_t* BR = (bf16_t*)((unsigned char*)F.out + DO_BR);
    bf16_t* Qb = (bf16_t*)(F.ws + WS_Q); bf16_t* Kb = (bf16_t*)(F.ws + WS_K); bf16_t* Vb = (bf16_t*)(F.ws + WS_V);
    bf16_t* Ub = (bf16_t*)(F.ws + WS_U); bf16_t* Sb = (bf16_t*)(F.ws + WS_S); bf16_t* GT = (bf16_t*)(F.ws + WS_GATES);

    if (IN(0)) { REFRESH(); p0_prologue(F); if (PROBE_REPEAT & 1) { __syncthreads(); p0_prologue(F); } }
    SEAM(0);
    bool fastx = false;
    if (IN(0) && IN(1)) {
        if (F.tid == 0) MISC[11] = (F.G == 256 && xb_ld(ctl + CW_BAR + XB_MISPLACED) == 0u) ? 1u : 0u;
        __syncthreads();
        fastx = XCC_LOCAL_SEAMS && MISC[11] != 0u;
    }
    if (IN(1)) {
        REFRESH();
        pg8::SchedDense S; S.init(MTOK / 256, 2560 / 256, F.G, (int)blockIdx.x); S.A = (const char*)XN; S.B = (const char*)(F.ws + WS_WCAT); S.tstep = 256u * DM * 2u;
        pg8::EpiProj E{Qb, GT, F.in[4], (float*)(F.ws + WS_KN2)};
        pg8::SchedDense S8; S8.init(MTOK / 256, 2048 / 256, F.G, (int)blockIdx.x); S8.A = (const char*)F.out + DO_XN8; S8.B = (const char*)(F.ws + WS_WG8); S8.tstep = 256u * DM;
        pg8::EpiGate E8{GT, F.in[4]};
#if USE_NAIVE_GEMM
        pg8::gemm_phase_naive<pg8::EpiProj, pg8::SchedDense, false, false>(DM, S, E);
#else
        pg8::gemm_phase<pg8::EpiProj, pg8::SchedDense, true, false, false>(F.lds, DM * 2, S, E);
        pg8::gemm_phase<pg8::EpiGate, pg8::SchedDense, true, false, false, true>(F.lds, DM, S8, E8);
        if (PROBE_REPEAT & 2) pg8::gemm_phase<pg8::EpiProj, pg8::SchedDense, true, false, false>(F.lds, DM * 2, S, E);
#endif
    }
    SEAML(1);
    if (IN(2)) {
        REFRESH();
        const float a1 = wave_sum(F.in[5][F.lane] * F.in[6][F.lane]), a2 = wave_sum(F.in[7][F.lane] * F.in[8][F.lane]);
        const float lam = __uint_as_float(__builtin_amdgcn_readfirstlane(__float_as_uint(expf(a1) - expf(a2) + 0.2f)));
#if USE_NAIVE_ATTN
        att::attn_naive(F, Qb, Kb, Vb, BR, F.in[9], lam);
#else
        float* park = (float*)((unsigned char*)F.out + DO_PARK) + (size_t)blockIdx.x * (NWAVES * 64 * 64);
        for (int rep = 0; rep < ((PROBE_REPEAT & 4) ? 2 : 1); ++rep)
        for (int v = F.vcu; v < NB * 32; v += F.G)
            for (int i = 0; i < 2; ++i) {
                int vv = v * 2 + i; asm volatile("" : "+s"(vv));
                const int vq = vv >> 1, ii = vv & 1, b = vq >> 5, pr = (vq >> 4) & 1, qb = vq & 15, h = ii == 0 ? (pr ? 2 : 3) : (pr ? 1 : 0);
                att::attn_unit(b, h, qb, Qb, Kb, Vb, (const float*)(F.ws + WS_KN2), BR, park, F.in[9], lam, (char*)lds);
            }
        if (F.G == 256 && ((F.vcu >> 4) & 1) == 0) {
            REFRESH();
            const int w30 = (F.vcu >> 5) * 16 + (F.vcu & 15);
            LAS float* scr = (LAS float*)(F.lds + F.wave * 16384);
            for (int r = w30 * NWAVES + F.wave; r < EXP_P2_ITEMS; r += 128 * NWAVES) expert_item(F, r, scr);
            __syncthreads();
        } else if (F.G != 256) { REFRESH(); LAS float* scr = (LAS float*)(F.lds + F.wave * 16384); for (int r = F.vcu * NWAVES + F.wave; r < EXP_P2_ITEMS; r += F.G * NWAVES) expert_item(F, r, scr); __syncthreads(); }
#endif
        REFRESH();
        for (int rep2 = 0; rep2 < ((PROBE_REPEAT & 1024) ? 2 : 1); ++rep2)
        for (int it = F.vcu; it < MTOK / 128; it += F.G) {
#if USE_NAIVE_SGU
            att::sgu_naive(it, Ub, Sb, F.in[12], F.in[10], F.in[11], F.in[13], BR, (char*)lds);
#else
            att::sgu_item(it, Ub, Sb, (const bf16_t*)(F.ws + WS_WSGU), F.in[10], F.in[11], F.in[13], BR, (char*)lds);
#endif
        }
    }
    SEAML(2);
    if (IN(3)) {
        REFRESH();
        pg8::SchedDense S; S.init(MTOK / 256, DM / 256, F.G, (int)blockIdx.x); S.A = (const char*)BR; S.B = (const char*)(F.ws + WS_WBR); S.tstep = 256u * DM * 2u;
        pg8::EpiMix E{GT, (bf16_t*)(F.ws + WS_MIXED)};
#if USE_NAIVE_GEMM
        pg8::gemm_phase_naive<pg8::EpiMix, pg8::SchedDense, false, true>(DM, S, E);
#else
        pg8::gemm_phase<pg8::EpiMix, pg8::SchedDense, true, false, true>(F.lds, DM * 2, S, E);
        if (PROBE_REPEAT & 8) pg8::gemm_phase<pg8::EpiMix, pg8::SchedDense, true, false, true>(F.lds, DM * 2, S, E);
#endif
    }
    SEAM(3);
    if (IN(4)) {
        REFRESH();
        pg8::SchedDense S; S.init(MTOK / 256, DM / 256, F.G, (int)blockIdx.x); S.A = (const char*)(F.ws + WS_MIXED); S.B = (const char*)(F.ws + WS_WOUT); S.tstep = 256u * DM * 2u;
        pg8::EpiRes E{F.in[0], (bf16_t*)(F.ws + WS_X1B)};
#if USE_NAIVE_GEMM
        pg8::gemm_phase_naive<pg8::EpiRes, pg8::SchedDense, false, false>(DM, S, E);
#else
        pg8::gemm_phase<pg8::EpiRes, pg8::SchedDense, true, false, false>(F.lds, DM * 2, S, E);
        if (PROBE_REPEAT & 16) pg8::gemm_phase<pg8::EpiRes, pg8::SchedDense, true, false, false>(F.lds, DM * 2, S, E);
#endif
    }
    SEAML(4);
    if (IN(5)) { REFRESH(); p5_router(F); if (PROBE_REPEAT & 32) p5_router(F); }
    SEAML(5);
    if (PROBE_REPEAT & 2048) { for (int i_ = 0; i_ < 10; ++i_) SEAM(5); }
    if (PROBE_REPEAT & 4096) { for (int i_ = 0; i_ < 10; ++i_) SEAML(5); }
    const int p6_first = fastx ? ((F.vcu & 31) < 16 ? (F.vcu >> 5) * 16 + (F.vcu & 31) : NB * NE) : F.vcu;
    if (IN(6)) { REFRESH(); p6_topk(F, p6_first); if (PROBE_REPEAT & 64) p6_topk(F, p6_first);
        { REFRESH();
          LAS float* scr = (LAS float*)(F.lds + 16384 + F.wave * 8704);
          if (F.G == 256) {
              const bool idle = p6_first >= NB * NE;
              const int me = idle ? (fastx ? (F.vcu >> 5) * 16 + (F.vcu & 31) - 16 : F.vcu - NB * NE) : p6_first;
              constexpr int SPLIT = EXP_P6_ITEMS * 5 / 8;
              const int lo_ = EXP_P2_ITEMS + (idle ? 0 : SPLIT), hi_ = EXP_P2_ITEMS + (idle ? SPLIT : EXP_P6_ITEMS);
              for (int r = lo_ + me * NWAVES + F.wave; r < hi_; r += 128 * NWAVES) expert_item(F, r, scr);
          } else {
              const int nidle = F.G > NB * NE ? F.G - NB * NE : F.G, me = F.G > NB * NE ? F.vcu - NB * NE : F.vcu;
              if (me >= 0) for (int r = EXP_P2_ITEMS + me * NWAVES + F.wave; r < EXP_P2_ITEMS + EXP_P6_ITEMS; r += nidle * NWAVES) expert_item(F, r, scr); } } }
    SEAM(6);
    if (IN(7)) {
        REFRESH();
        pg8::SchedMoe S; S.init(MROWS / 256, 4096 / 256, F.G, (int)blockIdx.x);
        S.A = (const char*)(F.ws + WS_H2); S.B = (const char*)(F.ws + WS_WGU); S.idx = (const int*)(F.ws + WS_IDX);
        S.a_bstride = (unsigned)SEQ * DM; S.a_rowbytes = 0; S.b_estride = 4096u * DM; S.b_tstep = 256u * DM; S.gather = true;
        pg8::EpiSwiglu E{(unsigned char*)(F.ws + WS_ACT)};
#if 1
        pg8::gemm_phase<pg8::EpiSwiglu, pg8::SchedMoe, true, true, false, true>(F.lds, DM, S, E);
        if (PROBE_REPEAT & 128) pg8::gemm_phase<pg8::EpiSwiglu, pg8::SchedMoe, true, true, false, true>(F.lds, DM, S, E);
#endif
    }
    SEAML(7);
    if (IN(8)) {
        REFRESH();
        pg8::SchedMoe S; S.init(MROWS / 256, DM / 256, F.G, (int)blockIdx.x);
        S.A = (const char*)(F.ws + WS_ACT); S.B = (const char*)(F.ws + WS_WD); S.idx = nullptr;
        S.a_bstride = 0; S.a_rowbytes = (unsigned)FF; S.b_estride = (unsigned)DM * FF; S.b_tstep = 256u * FF; S.gather = false;
        pg8::EpiDown E{(const float*)(F.ws + WS_GV), (unsigned char*)(F.ws + WS_Y)};
#if 1
        pg8::gemm_phase<pg8::EpiDown, pg8::SchedMoe, true, false, false, true>(F.lds, FF, S, E);
        if (PROBE_REPEAT & 256) pg8::gemm_phase<pg8::EpiDown, pg8::SchedMoe, true, false, false, true>(F.lds, FF, S, E);
#endif
    }
    SEAM(8);
    if (IN(9)) { REFRESH(); if (PROBE_REPEAT & 512) p9_final(F, (float*)(F.ws + WS_ACT)); p9_final(F, F.out); }
#undef IN
#undef SEAM
}

extern "C" void kernel_launch(void* const* d_in, const int* in_sizes, int n_in, void* d_out, int out_size, void* d_ws, size_t ws_size, hipStream_t stream) {
    static int grid = 0;
    if (grid == 0) {
        if (n_in != 22 || in_sizes[0] != MTOK * DM || out_size != MTOK * DM || ws_size < WS_END) { fprintf(stderr, "kernel_launch: shape/workspace mismatch (n_in %d, ws %zu)\n", n_in, ws_size); grid = -1; return; }
        int dev = 0, cus = 0;
        if (hipGetDevice(&dev) != hipSuccess || hipDeviceGetAttribute(&cus, hipDeviceAttributeMultiprocessorCount, dev) != hipSuccess) { grid = -1; return; }
        if (hipFuncSetAttribute((const void*)fwd_kernel, hipFuncAttributeMaxDynamicSharedMemorySize, LDS_BYTES) != hipSuccess) { fprintf(stderr, "kernel_launch: hipFuncSetAttribute failed\n"); grid = -1; return; }
        int per_cu = 0;
        if (hipOccupancyMaxActiveBlocksPerMultiprocessor(&per_cu, (const void*)fwd_kernel, NTHREADS, LDS_BYTES) != hipSuccess || per_cu < 1) fprintf(stderr, "kernel_launch: occupancy query reports %d\n", per_cu);
        (void)hipGetLastError();
        grid = cus;
    }
    if (grid < 0) return;
    if (hipMemsetAsync((char*)d_ws + WS_CTL, 0, CTL_ZERO_BYTES, stream) != hipSuccess) return;
    Args a{};
    for (int i = 0; i < 22; ++i) a.in[i] = (const float*)d_in[i];
    a.out = (float*)d_out; a.ws = (unsigned char*)d_ws;
    if (MK_N_LAUNCHES == 1) { a.ph_lo = 0; a.ph_hi = NPHASE; hipLaunchKernelGGL(fwd_kernel, dim3(grid), dim3(NTHREADS), LDS_BYTES, stream, a); }
    else for (int p = 0; p < NPHASE; ++p) { a.ph_lo = p; a.ph_hi = p + 1; hipLaunchKernelGGL(fwd_kernel, dim3(grid), dim3(NTHREADS), LDS_BYTES, stream, a); }
}
```
